# Optimizing an MI355X kernel written in HIP

```python
import jax, jax.numpy as jnp
from jax import lax
import numpy as np

D_MODEL = 1024
BATCH = 16
SEQ = 256
DEPTH = 1
DEC_BATCH = 2
DEC_SEQ = 1024
PAST_LEN = 512

GRID_W = 64
D_MIX = D_MODEL
D_A = D_MIX // 2
D_B = D_MIX - D_A
H_A = 4
H_B = 4
DV_A = D_A // H_A
DK_A = DV_A // 2
DV_B = D_B // H_B
DK_B = DV_B // 2
R_ALPHA = 16
TAU_GLA = 16.0
CONV_K = 3
CHUNK = 64
D_FF = 4 * D_MODEL
EPS = 1e-6
SPLIT_SIZES = (H_A * DK_A, H_A * DK_A, D_A, D_A, 2 * R_ALPHA,
               H_B * DK_B, H_B * DK_B, D_B, D_B, 4 * H_B)
D_IN = sum(SPLIT_SIZES)

kernel_name = "hybrid_gla_mlstm_diffusion_step"


def rmsnorm(x, w):
    x32 = x.astype(jnp.float32)
    y = x32 * lax.rsqrt(jnp.mean(x32 * x32, axis=-1, keepdims=True) + EPS)
    return (y * w.astype(jnp.float32)).astype(x.dtype)


def head_rmsnorm(o, w):
    y = o * lax.rsqrt(jnp.mean(o * o, axis=-1, keepdims=True) + EPS)
    B, T, H, dv = o.shape
    return y.reshape(B, T, H * dv) * w.astype(jnp.float32)


def rev(a):
    return jnp.flip(a, axis=1)


def to_chunks(a):
    B, T, H = a.shape[:3]
    N = T // CHUNK
    if a.ndim == 4:
        return a.reshape(B, N, CHUNK, H, a.shape[-1]).transpose(1, 0, 3, 2, 4)
    return a.reshape(B, N, CHUNK, H).transpose(1, 0, 3, 2)


def from_chunks(o):
    N, B, H, L, d = o.shape
    return o.transpose(1, 0, 3, 2, 4).reshape(B, N * L, H, d)


def grid_dwconv(u, w, rows):
    B, T, C = u.shape
    img = u.reshape(B, rows, T // rows, C)
    out = lax.conv_general_dilated(img, w[:, :, None, :].astype(u.dtype), window_strides=(1, 1), padding='SAME',
                                   dimension_numbers=('NHWC', 'HWIO', 'NHWC'), feature_group_count=C)
    return out.reshape(B, T, C)


def gla_scan(q, k, v, g, S0):
    mask = jnp.tril(jnp.ones((CHUNK, CHUNK), dtype=bool))

    def step(S, inp):
        qc, kc, vc, gc = inp
        b = jnp.cumsum(gc, axis=2)
        diff = jnp.where(mask[:, :, None], b[:, :, :, None, :] - b[:, :, None, :, :], -jnp.inf)
        scores = jnp.einsum('bhtd,bhsd,bhtsd->bhts', qc, kc, jnp.exp(diff))
        o = jnp.einsum('bhts,bhsv->bhtv', scores, vc) + jnp.einsum('bhtd,bhdv->bhtv', qc * jnp.exp(b), S)
        bL = b[:, :, -1]
        S = jnp.exp(bL)[..., None] * S + jnp.einsum('bhsd,bhsv->bhdv', kc * jnp.exp(bL[:, :, None] - b), vc)
        return S, o

    S, o = lax.scan(step, S0.astype(jnp.float32), (to_chunks(q), to_chunks(k), to_chunks(v), to_chunks(g)))
    return from_chunks(o), S


def mlstm_scan(q, k, v, ig, lf, C0, n0, m0):
    mask = jnp.tril(jnp.ones((CHUNK, CHUNK), dtype=bool))

    def step(carry, inp):
        C, n, m = carry
        qc, kc, vc, ic, fc = inp
        F = jnp.cumsum(fc, axis=-1)
        D = jnp.where(mask, F[..., :, None] - F[..., None, :] + ic[..., None, :], -jnp.inf)
        inter = F + m[..., None]
        mt = jnp.maximum(inter, jnp.max(D, axis=-1))
        w_inter = jnp.exp(inter - mt)
        s = jnp.einsum('bhtd,bhsd->bhts', qc, kc) * jnp.exp(D - mt[..., None])
        num = jnp.einsum('bhts,bhsv->bhtv', s, vc) + w_inter[..., None] * jnp.einsum('bhtd,bhdv->bhtv', qc, C)
        den = jnp.sum(s, axis=-1) + w_inter * jnp.einsum('bhtd,bhd->bht', qc, n)
        h = num / jnp.maximum(jnp.abs(den), jnp.exp(-mt))[..., None]
        FL = F[..., -1]
        m_new = mt[..., -1]
        a = jnp.exp(FL + m - m_new)
        wk = jnp.exp(FL[..., None] - F + ic - m_new[..., None])
        C = a[..., None, None] * C + jnp.einsum('bhs,bhsd,bhsv->bhdv', wk, kc, vc)
        n = a[..., None] * n + jnp.einsum('bhs,bhsd->bhd', wk, kc)
        return (C, n, m_new), h

    f32 = jnp.float32
    (C, n, m), h = lax.scan(step, (C0.astype(f32), n0.astype(f32), m0.astype(f32)),
                            (to_chunks(q), to_chunks(k), to_chunks(v), to_chunks(ig), to_chunks(lf)))
    return from_chunks(h), C, n, m


def mixer(h, rows, S_gla, C_m, n_m, m_m, w_in, w_alpha2, b_alpha, b_mgate, conv_w, gnorm_a_w, gnorm_b_w, w_out):
    f32 = jnp.float32
    B, T, _ = h.shape
    z = h @ w_in
    qa, ka, va, ga, ra, qb, kb, vb, ob, gb = jnp.split(z, np.cumsum(SPLIT_SIZES)[:-1].tolist(), axis=-1)
    qa = qa.astype(f32).reshape(B, T, H_A, DK_A) * (DK_A ** -0.5)
    ka = ka.astype(f32).reshape(B, T, H_A, DK_A)
    va = va.astype(f32).reshape(B, T, H_A, DV_A)
    ra = ra.astype(f32).reshape(B, T, 2, R_ALPHA)
    loga = jax.nn.log_sigmoid(jnp.einsum('btzr,zrk->btzk', ra, w_alpha2.astype(f32)) + b_alpha.astype(f32)) / TAU_GLA
    loga = loga.reshape(B, T, 2, H_A, DK_A)
    oa_f, Sa_f = gla_scan(qa, ka, va, loga[:, :, 0], S_gla[:, 0])
    oa_b, Sa_b = gla_scan(rev(qa), rev(ka), rev(va), rev(loga[:, :, 1]), S_gla[:, 1])
    out_a = head_rmsnorm(oa_f + rev(oa_b), gnorm_a_w) * jax.nn.silu(ga.astype(f32))
    qk = jax.nn.silu(grid_dwconv(jnp.concatenate([qb, kb], axis=-1), conv_w, rows)).astype(f32)
    qb, kb = jnp.split(qk, 2, axis=-1)
    qb = qb.reshape(B, T, H_B, DK_B) * (DK_B ** -0.5)
    kb = kb.reshape(B, T, H_B, DK_B)
    vb = vb.astype(f32).reshape(B, T, H_B, DV_B)
    gates = gb.astype(f32).reshape(B, T, 4, H_B) + b_mgate.astype(f32)
    hb_f, C_f, n_f, m_f = mlstm_scan(qb, kb, vb, gates[:, :, 0], jax.nn.log_sigmoid(gates[:, :, 1]),
                                     C_m[:, 0], n_m[:, 0], m_m[:, 0])
    hb_b, C_b, n_b, m_b = mlstm_scan(rev(qb), rev(kb), rev(vb), rev(gates[:, :, 2]),
                                     rev(jax.nn.log_sigmoid(gates[:, :, 3])), C_m[:, 1], n_m[:, 1], m_m[:, 1])
    out_b = head_rmsnorm(hb_f + rev(hb_b), gnorm_b_w) * jax.nn.sigmoid(ob.astype(f32))
    out = jnp.concatenate([out_a, out_b], axis=-1).astype(h.dtype) @ w_out
    new_states = (jnp.stack([Sa_f, Sa_b], axis=1), jnp.stack([C_f, C_b], axis=1),
                  jnp.stack([n_f, n_b], axis=1), jnp.stack([m_f, m_b], axis=1))
    return out, new_states


def block(x, cond, rows, states, w_ada, b_ada, norm1_w, norm2_w, mix_params, w_ff1, w_ff2):
    mod = (jax.nn.silu(cond) @ w_ada + b_ada)[:, None, :]
    sh1, sc1, g1, sh2, sc2, g2 = jnp.split(mod.astype(x.dtype), 6, axis=-1)
    h = rmsnorm(x, norm1_w) * (1 + sc1) + sh1
    y, new_states = mixer(h, rows, *states, *mix_params)
    x = x + g1 * y
    h = rmsnorm(x, norm2_w) * (1 + sc2) + sh2
    x = x + g2 * (jnp.square(jax.nn.relu(h @ w_ff1)) @ w_ff2)
    return x, new_states


def setup_inputs(seed: int = 0) -> dict:
    key = jax.random.key(seed)
    ks = jax.random.split(key, 24)
    f32 = jnp.float32

    def nrm(k, shape, scale):
        return jax.random.normal(k, shape, f32) * scale

    gate_offset = jnp.array([0.0, 3.0, 0.0, 3.0], f32)[None, :, None]
    return {
        "x_prompt": nrm(ks[0], (BATCH, SEQ, D_MODEL), 1.0),
        "x_sample": nrm(ks[1], (DEC_BATCH, DEC_SEQ, D_MODEL), 1.0),
        "c": nrm(ks[2], (DEC_BATCH, D_MODEL), 1.0),
        "state_gla": nrm(ks[3], (DEC_BATCH, DEPTH, 2, H_A, DK_A, DV_A), 0.5),
        "state_mlstm_C": nrm(ks[4], (DEC_BATCH, DEPTH, 2, H_B, DK_B, DV_B), 0.5),
        "state_mlstm_n": jnp.abs(nrm(ks[5], (DEC_BATCH, DEPTH, 2, H_B, DK_B), 0.5)),
        "state_mlstm_m": nrm(ks[6], (DEC_BATCH, DEPTH, 2, H_B), 0.5),
        "c_ctx": nrm(ks[7], (D_MODEL,), 1.0),
        "w_ada": nrm(ks[8], (DEPTH, D_MODEL, 6 * D_MODEL), 0.5 * D_MODEL ** -0.5),
        "b_ada": nrm(ks[9], (DEPTH, 6 * D_MODEL), 0.02),
        "norm1_w": 1.0 + nrm(ks[10], (DEPTH, D_MODEL), 0.02),
        "norm2_w": 1.0 + nrm(ks[11], (DEPTH, D_MODEL), 0.02),
        "w_in": nrm(ks[12], (DEPTH, D_MODEL, D_IN), D_MODEL ** -0.5),
        "w_alpha2": nrm(ks[13], (DEPTH, 2, R_ALPHA, H_A * DK_A), R_ALPHA ** -0.5),
        "b_alpha": nrm(ks[14], (DEPTH, 2, H_A * DK_A), 0.1),
        "b_mgate": gate_offset + nrm(ks[15], (DEPTH, 4, H_B), 0.1),
        "conv_w": nrm(ks[16], (DEPTH, CONV_K, CONV_K, 2 * H_B * DK_B), 1.0 / CONV_K),
        "gnorm_a_w": 1.0 + nrm(ks[17], (DEPTH, D_A), 0.02),
        "gnorm_b_w": 1.0 + nrm(ks[18], (DEPTH, D_B), 0.02),
        "w_out": nrm(ks[19], (DEPTH, D_MIX, D_MODEL), D_MIX ** -0.5),
        "w_ff1": nrm(ks[20], (DEPTH, D_MODEL, D_FF), D_MODEL ** -0.5),
        "w_ff2": nrm(ks[21], (DEPTH, D_FF, D_MODEL), D_FF ** -0.5),
        "final_norm_w": 1.0 + nrm(ks[22], (D_MODEL,), 0.02),
    }


def reference(x_prompt, x_sample, c, state_gla, state_mlstm_C, state_mlstm_n, state_mlstm_m, c_ctx,
              w_ada, b_ada, norm1_w, norm2_w, w_in, w_alpha2, b_alpha, b_mgate, conv_w,
              gnorm_a_w, gnorm_b_w, w_out, w_ff1, w_ff2, final_norm_w):
    f32 = jnp.float32
    Bp = x_prompt.shape[0]
    rows_lat = x_sample.shape[1] // GRID_W
    zero_states = (jnp.zeros((Bp, 2, H_A, DK_A, DV_A), f32), jnp.zeros((Bp, 2, H_B, DK_B, DV_B), f32),
                   jnp.zeros((Bp, 2, H_B, DK_B), f32), jnp.zeros((Bp, 2, H_B), f32))
    xp = x_prompt
    xs = x_sample
    s_gla, s_C, s_n, s_m = [], [], [], []
    for l in range(DEPTH):
        mix_params = (w_in[l], w_alpha2[l], b_alpha[l], b_mgate[l], conv_w[l], gnorm_a_w[l], gnorm_b_w[l], w_out[l])
        xp, ctx_states = block(xp, c_ctx[None, :], 1, zero_states, w_ada[l], b_ada[l], norm1_w[l], norm2_w[l],
                               mix_params, w_ff1[l], w_ff2[l])
        s_gla.append(ctx_states[0]); s_C.append(ctx_states[1]); s_n.append(ctx_states[2]); s_m.append(ctx_states[3])
        cached = (state_gla[:, l], state_mlstm_C[:, l], state_mlstm_n[:, l], state_mlstm_m[:, l])
        xs, _ = block(xs, c, rows_lat, cached, w_ada[l], b_ada[l], norm1_w[l], norm2_w[l],
                      mix_params, w_ff1[l], w_ff2[l])
    y_prompt = rmsnorm(xp, final_norm_w)
    y_sample = rmsnorm(xs, final_norm_w)
    dt = x_prompt.dtype
    new_state_gla = jnp.stack(s_gla, axis=1).astype(dt)
    new_state_mlstm_C = jnp.stack(s_C, axis=1).astype(dt)
    new_state_mlstm_n = jnp.stack(s_n, axis=1).astype(dt)
    new_state_mlstm_m = jnp.stack(s_m, axis=1).astype(dt)
    return (y_prompt, y_sample, new_state_gla, new_state_mlstm_C, new_state_mlstm_n, new_state_mlstm_m)
```

```cpp
#include <hip/hip_runtime.h>
#include <hip/hip_cooperative_groups.h>
#include <cstdio>
#include <cstdint>
namespace cg = cooperative_groups;

#define LAS __attribute__((address_space(3)))
typedef unsigned short bf16_t;
typedef short bf16x8 __attribute__((ext_vector_type(8)));
typedef float f32x4 __attribute__((ext_vector_type(4)));
typedef unsigned u32x4 __attribute__((ext_vector_type(4)));
typedef unsigned u32x2 __attribute__((ext_vector_type(2)));

constexpr int DM = 1024, NTOK = 6144, NPR = 4096, DIN = 3120, LDZ = 3328, DFF = 4096;
constexpr int QA = 0, KA = 256, VA = 512, GA = 1024, RA = 1536, QB = 1568, KB = 1824, VB = 2080, OB = 2592, GB = 3104;
constexpr int NWAVES = 8, NTHR = 512;
constexpr float EPS = 1e-6f;

constexpr size_t WS_MOD = 0;
constexpr size_t WS_BAR = 73728;
constexpr size_t WS_ZERO_BYTES = 73728 + 5504 * 4;
constexpr size_t WS_WIN = 131072;
constexpr size_t WS_WOUT = WS_WIN + (size_t)LDZ * DM * 2;
constexpr size_t WS_W1 = WS_WOUT + (size_t)DM * DM * 2;
constexpr size_t WS_W2 = WS_W1 + (size_t)DFF * DM * 2;
constexpr size_t WS_XN = WS_W2 + (size_t)DFF * DM * 2;
constexpr size_t WS_Z = WS_XN + (size_t)NTOK * DM * 2;
constexpr size_t WS_MIX = WS_Z + (size_t)NTOK * LDZ * 2;
constexpr size_t WS_X1 = WS_MIX + (size_t)NTOK * DM * 2;
constexpr size_t WS_X2B = WS_X1 + (size_t)NTOK * DM * 4;
constexpr size_t WS_U = WS_X2B + (size_t)NTOK * DM * 4;
constexpr size_t WS_VEC = WS_U + (size_t)NTOK * DFF * 2;
constexpr size_t WS_STW = WS_VEC + (size_t)1536 * 256 * 4;
constexpr size_t WS_QK = WS_STW + (size_t)1536 * 8192 * 2;
constexpr size_t WS_END = WS_QK + (size_t)1536 * 8192 * 2;

#ifndef DUP
#define DUP 0
#endif
constexpr int LDS_BYTES = 132 * 1024;

struct Args {
    const float* x_prompt; const float* x_sample; const float* c; const float* st_gla; const float* st_C; const float* st_n; const float* st_m; const float* c_ctx;
    const float* w_ada; const float* b_ada; const float* norm1_w; const float* norm2_w; const float* w_in; const float* w_alpha2; const float* b_alpha; const float* b_mgate;
    const float* conv_w; const float* gnorm_a_w; const float* gnorm_b_w; const float* w_out; const float* w_ff1; const float* w_ff2; const float* final_norm_w;
    float* out; unsigned char* ws;
};

__device__ __forceinline__ int fresh_tid() { int t = threadIdx.x; asm volatile("" : "+v"(t)); return t; }
__device__ __forceinline__ float bflo(unsigned w) { return __uint_as_float(w << 16); }
__device__ __forceinline__ float bfhi(unsigned w) { return __uint_as_float(w & 0xffff0000u); }
typedef __bf16 bf16x2v_ __attribute__((ext_vector_type(2)));
typedef float f32x2v_ __attribute__((ext_vector_type(2)));
__device__ __forceinline__ unsigned cvt_pk_bf16(float lo, float hi) { const f32x2v_ f = {lo, hi}; const bf16x2v_ b = __builtin_convertvector(f, bf16x2v_); return __builtin_bit_cast(unsigned, b); }
__device__ __forceinline__ bf16_t f2bf1(float x) { return (bf16_t)(cvt_pk_bf16(x, x) & 0xffffu); }
__device__ __forceinline__ float logsig(float x) { return fminf(x, 0.f) - __logf(1.f + __expf(-fabsf(x))); }
__device__ __forceinline__ float sigmoidf_(float x) { return 1.f / (1.f + __expf(-x)); }
__device__ __forceinline__ float siluf_(float x) { return x / (1.f + __expf(-x)); }
__device__ __forceinline__ float wave_sum(float v) {
#pragma unroll
    for (int o = 1; o < 64; o <<= 1) v += __shfl_xor(v, o);
    return v;
}
__device__ __forceinline__ float scan_sum(float v, int lane, int rev) {
#pragma unroll
    for (int o = 1; o < 64; o <<= 1) {
        const float t = rev ? __shfl_down(v, o) : __shfl_up(v, o);
        const bool ok = rev ? (lane + o < 64) : (lane >= o);
        v += ok ? t : 0.f;
    }
    return v;
}
__device__ __forceinline__ float scan_max(float v, int lane, int rev) {
#pragma unroll
    for (int o = 1; o < 64; o <<= 1) {
        const float t = rev ? __shfl_down(v, o) : __shfl_up(v, o);
        const bool ok = rev ? (lane + o < 64) : (lane >= o);
        v = ok ? fmaxf(v, t) : v;
    }
    return v;
}
__device__ __forceinline__ void unpack8(const u32x4 a, float (&f)[8]) {
    f[0] = bflo(a.x); f[1] = bfhi(a.x); f[2] = bflo(a.y); f[3] = bfhi(a.y); f[4] = bflo(a.z); f[5] = bfhi(a.z); f[6] = bflo(a.w); f[7] = bfhi(a.w);
}
__device__ __forceinline__ u32x4 pack8(const float (&f)[8]) {
    u32x4 o; o.x = cvt_pk_bf16(f[0], f[1]); o.y = cvt_pk_bf16(f[2], f[3]); o.z = cvt_pk_bf16(f[4], f[5]); o.w = cvt_pk_bf16(f[6], f[7]); return o;
}


#define XB_TMO      128
#define XB_XCNT(j)  (256  + 64 * (j))
#define XB_XSUB(j)  (1280 + 64 * (j))
#define XB_XGEN(j)  (2304 + 64 * (j))
#define XB_TOP      3328
#define XB_TOPGEN   3392
#define XB_LSUB(j)  (3456 + 64 * (j))
#define XB_LGEN(j)  (4480 + 64 * (j))
#define XCD_BAR_WORDS 5504
#define XB_SPIN_CAP (1u << 18)
__device__ __forceinline__ unsigned xb_ld(unsigned* p)              { return __hip_atomic_load(p, __ATOMIC_RELAXED, __HIP_MEMORY_SCOPE_AGENT); }
__device__ __forceinline__ unsigned xb_add(unsigned* p, unsigned v) { return __hip_atomic_fetch_add(p, v, __ATOMIC_RELAXED, __HIP_MEMORY_SCOPE_AGENT); }
__device__ __forceinline__ unsigned xb_xcc_id() { return (unsigned)__builtin_amdgcn_s_getreg((3 << 11) | 20) & 0xFu; }
#define XB_SPIN(cond, bar) do { unsigned _sp = 0; while (cond) { __builtin_amdgcn_s_sleep(1); \
    if ((++_sp & 255u) == 0u) { if (xb_ld(&(bar)[XB_TMO])) break; if (_sp > XB_SPIN_CAP) { atomicAdd(&(bar)[XB_TMO], 1u); break; } } } } while (0)
struct XcdBarrier { unsigned* bar; unsigned x; volatile LAS unsigned* st; };
__device__ __forceinline__ XcdBarrier xcd_barrier_post(unsigned* bar, volatile LAS unsigned* st) {
    XcdBarrier b; b.bar = bar; b.x = xb_xcc_id(); b.st = st;
    if (threadIdx.x == 0) { st[2] = xb_add(&bar[XB_XCNT(b.x)], 1u); st[3] = b.x; }
    return b;
}
__device__ __forceinline__ void xcd_barrier_complete(unsigned* bar, unsigned x, unsigned& nloc, unsigned& nx) {
    const unsigned G = gridDim.x * gridDim.y * gridDim.z;
    unsigned sum, cnt, mine, sp = 0u;
    for (;;) {
        sum = 0u; cnt = 0u; mine = 0u;
#pragma unroll
        for (unsigned j = 0; j < 16; ++j) { const unsigned c = xb_ld(&bar[XB_XCNT(j)]); sum += c; cnt += (c > 0u) ? 1u : 0u; mine = (j == x) ? c : mine; }
        if (sum == G) break;
        __builtin_amdgcn_s_sleep(1);
        if ((++sp & 255u) == 0u) { if (xb_ld(&bar[XB_TMO])) break; if (sp > XB_SPIN_CAP) { atomicAdd(&bar[XB_TMO], 1u); break; } }
    }
    nloc = mine > 0u ? mine : 1u; nx = cnt > 0u ? cnt : 1u;
}
__device__ __forceinline__ void xcd_barrier(const XcdBarrier& b) {
    asm volatile("s_waitcnt vmcnt(0)" ::: "memory");
    __syncthreads();
    if (threadIdx.x == 0) {
        unsigned* bar = b.bar;
        __builtin_amdgcn_s_waitcnt(0);
        unsigned nloc = b.st[0], nx = b.st[1];
        if (nloc == 0u) { xcd_barrier_complete(bar, b.x, nloc, nx); b.st[0] = nloc; b.st[1] = nx; }
        const unsigned old = xb_add(&bar[XB_XSUB(b.x)], 1u);
        const unsigned gen = old / nloc;
        if (old + 1u == (gen + 1u) * nloc) {
            __builtin_amdgcn_fence(__ATOMIC_RELEASE, "agent");
            asm volatile("s_waitcnt vmcnt(0)" ::: "memory");
            const unsigned og = xb_add(&bar[XB_TOP], 1u);
            const unsigned tg = og / nx;
            if (og + 1u == (tg + 1u) * nx) xb_add(&bar[XB_TOPGEN], 1u);
            else XB_SPIN(xb_ld(&bar[XB_TOPGEN]) == tg, bar);
            __builtin_amdgcn_fence(__ATOMIC_ACQUIRE, "agent");
            xb_add(&bar[XB_XGEN(b.x)], 1u);
            asm volatile("s_waitcnt vmcnt(0)" ::: "memory");
        } else {
            XB_SPIN(xb_ld(&bar[XB_XGEN(b.x)]) == gen, bar);
            __builtin_amdgcn_fence(__ATOMIC_ACQUIRE, "agent");
            asm volatile("s_waitcnt vmcnt(0)" ::: "memory");
        }
    }
    __syncthreads();
}

__device__ __forceinline__ void xcd_local_barrier(const XcdBarrier& b) {
    asm volatile("s_waitcnt vmcnt(0)" ::: "memory");
    __syncthreads();
    if (threadIdx.x == 0) {
        unsigned* bar = b.bar;
        __builtin_amdgcn_s_waitcnt(0);
        const unsigned nloc = b.st[0];
        const unsigned old = xb_add(&bar[XB_LSUB(b.x)], 1u);
        const unsigned gen = old / nloc;
        if (old + 1u == (gen + 1u) * nloc) xb_add(&bar[XB_LGEN(b.x)], 1u);
        else XB_SPIN(xb_ld(&bar[XB_LGEN(b.x)]) == gen, bar);
        __builtin_amdgcn_fence(__ATOMIC_ACQUIRE, "agent");
        asm volatile("s_waitcnt vmcnt(0)" ::: "memory");
    }
    __syncthreads();
}

namespace pg8 {
constexpr int BM = 256, BK = 64, HALF = 128, HTB = HALF * BK * 2, STAGE_BYTES = 8 * HTB, NXCD = 8, WGM = 8;
__host__ __device__ __forceinline__ int lds_byte(int r, int c) { const int st = (r >> 4) * 2 + (c >> 5), rr = r & 15, cc = c & 31, ob = rr * 64 + cc * 2; return st * 1024 + (ob ^ (((ob >> 9) & 1) << 5)); }
__host__ __device__ __forceinline__ void stage_rc(int b, int& R, int& C) { const int st = b / 1024, sb = b % 1024, swz = sb ^ (((sb >> 9) & 1) << 5); R = (st >> 1) * 16 + swz / 64; C = (st & 1) * 32 + (swz % 64) / 2; }
__host__ __device__ __forceinline__ int perm32(int rho) { const int n = rho >> 4, i = rho & 15; return 8 * (i >> 2) + 4 * n + (i & 3); }

struct Unit { int pm, pn, ks; };
struct Gemm { const bf16_t* A; const bf16_t* Bt; int lda, ldb, K; };

struct Order {
    int nM, nN, nmn, ntot, G, c, aff, ks_;
    __device__ void init(int M, int N, int KS, int G_, int c_) { nM = M / BM; nN = N / BM; nmn = nM * nN; ntot = nmn * KS; G = G_; c = c_; ks_ = KS; aff = (G_ == 256 && nM == 24) ? 1 : 0; }
    __device__ bool next(int i, Unit& u) const {
        int pm, pn, ks;
        if (aff) {
            const int x = c & 7, li = c >> 3, per = nN * ks_, e = li + 32 * i;
            if (e >= 3 * per) return false;
            const int r = e / 3, q = e - 3 * r;
            pm = 3 * x + q; pn = r / ks_; ks = r - pn * ks_;
        } else {
            const int L = i * G + c; if (L >= ntot) return false;
            ks = L / nmn; int wgid = L - ks * nmn;
            { const int q = nmn / NXCD, r = nmn % NXCD, xcd = wgid % NXCD, off = wgid / NXCD; wgid = (xcd < r ? xcd * (q + 1) : r * (q + 1) + (xcd - r) * q) + off; }
            const int nig = WGM * nN, gid = wgid / nig, fm = gid * WGM, gsz = (nM - fm) < WGM ? (nM - fm) : WGM;
            pm = fm + ((wgid % nig) % gsz); pn = (wgid % nig) / gsz;
        }
        u.pm = pm; u.pn = pn; u.ks = ks; return true;
    }
};

template <int ACT  > struct EpiBf16 {
    static constexpr bool PERM = true;
    bf16_t* O; int ldc;
    __device__ __forceinline__ void operator()(const f32x4 (&acc)[2][2][4][2], const Unit& u, int wr, int wc, int fr, int fq) const {
        const int row0 = u.pm * BM + wr * 64 + fr, col0 = u.pn * BM + wc * 32 + 8 * fq;
#pragma unroll
        for (int ai = 0; ai < 2; ++ai)
#pragma unroll
            for (int m = 0; m < 4; ++m) { bf16_t* rowp = O + (size_t)(row0 + ai * HALF + m * 16) * ldc + col0;
#pragma unroll
                for (int bj = 0; bj < 2; ++bj) { f32x4 v0 = acc[ai][bj][m][0], v1 = acc[ai][bj][m][1];
                    if (ACT == 1) {
#pragma unroll
                        for (int j = 0; j < 4; ++j) { const float a = fmaxf(v0[j], 0.f), b = fmaxf(v1[j], 0.f); v0[j] = a * a; v1[j] = b * b; } }
                    u32x4 w; w.x = cvt_pk_bf16(v0[0], v0[1]); w.y = cvt_pk_bf16(v0[2], v0[3]); w.z = cvt_pk_bf16(v1[0], v1[1]); w.w = cvt_pk_bf16(v1[2], v1[3]);
                    *(u32x4*)(rowp + bj * HALF) = w; } }
    }
};
struct EpiRes {
    static constexpr bool PERM = false;
    const float* xp; const float* xs;
    float* o0; float* o1;
    const float* mod; const float* bada; int goff; int mode;
    __device__ __forceinline__ void operator()(const f32x4 (&acc)[2][2][4][2], const Unit& u, int wr, int wc, int fr, int fq) const {
        const int row0 = u.pm * BM + wr * 64 + fr, col0 = u.pn * BM + wc * 32 + 4 * fq;
        const int cond = u.pm < 16 ? 0 : 1 + ((u.pm - 16) >> 2);
        f32x4 gv[2][2];
#pragma unroll
        for (int bj = 0; bj < 2; ++bj)
#pragma unroll
            for (int n = 0; n < 2; ++n) gv[bj][n] = *(const f32x4*)(mod + cond * 6144 + goff + col0 + bj * HALF + n * 16) + *(const f32x4*)(bada + goff + col0 + bj * HALF + n * 16);
        float* outb = (u.ks == 0) ? o0 : o1;
#pragma unroll
        for (int ai = 0; ai < 2; ++ai)
#pragma unroll
            for (int m = 0; m < 4; ++m) { const int r = row0 + ai * HALF + m * 16;
                const float* bp = nullptr;
                if (mode == 0) bp = (r < NPR ? xp + (size_t)r * DM : xs + (size_t)(r - NPR) * DM) + col0;
                else if (u.ks == 0) bp = o0 + (size_t)r * DM + col0;
                float* op = outb + (size_t)r * DM + col0;
#pragma unroll
                for (int bj = 0; bj < 2; ++bj)
#pragma unroll
                    for (int n = 0; n < 2; ++n) { f32x4 v = gv[bj][n] * acc[ai][bj][m][n]; if (bp) v += *(const f32x4*)(bp + bj * HALF + n * 16); *(f32x4*)(op + bj * HALF + n * 16) = v; } }
    }
};

template <class Epi>
__device__ __forceinline__ void gemm_phase(LAS unsigned char* lds, const Gemm g, const Order& S, const Epi& E) {
    const int tid = fresh_tid(), wid = __builtin_amdgcn_readfirstlane(tid >> 6), lane = tid & 63, wr = wid >> 2, wc = wid & 3, fr = lane & 15, fq = lane >> 4;
    const int nt = g.K / BK;
    unsigned voffA[2], voffB[2];
#pragma unroll
    for (int i = 0; i < 2; ++i) { int R, C; stage_rc(tid * 16 + i * 8192, R, C); const int Rb = Epi::PERM ? ((R & ~31) + perm32(R & 31)) : R;
        voffA[i] = (unsigned)(R * g.lda + C) * 2u; voffB[i] = (unsigned)(Rb * g.ldb + C) * 2u; }
    const size_t kstep = (size_t)(BK * 2);
    const size_t hstepA = (size_t)HALF * g.lda * 2, hstepB = (size_t)HALF * g.ldb * 2;
    const size_t tstepA = 2 * hstepA, tstepB = 2 * hstepB;
    const unsigned ldsw = (unsigned)wid * 1024u;
    const int aoff = lds_byte(wr * 64 + fr, fq * 8), boff = lds_byte(wc * 32 + fr, fq * 8);
#define PG8_SA(b, h) (((b) * 2 + (h)) * HTB)
#define PG8_SB(b, h) ((4 + (b) * 2 + (h)) * HTB)
#define PG8_STAGE(bufoff, gbase, voff) do { _Pragma("unroll") for (int _i = 0; _i < 2; ++_i) \
        __builtin_amdgcn_global_load_lds((const unsigned*)((const char*)(gbase) + (voff)[_i]), (LAS unsigned*)(lds + (bufoff) + ldsw + _i * 8192), 16, 0, 0); } while (0)
#define PG8_LDA(dst, b, h) do { _Pragma("unroll") for (int m = 0; m < 4; ++m) _Pragma("unroll") for (int k = 0; k < 2; ++k) dst[m][k] = *(const LAS bf16x8*)(lds + PG8_SA(b, h) + aoff + m * 2048 + k * 1024); } while (0)
#define PG8_LDB(dst, b, h) do { _Pragma("unroll") for (int n = 0; n < 2; ++n) _Pragma("unroll") for (int k = 0; k < 2; ++k) dst[n][k] = *(const LAS bf16x8*)(lds + PG8_SB(b, h) + boff + n * 2048 + k * 1024); } while (0)
#define PG8_MMA(ai, bj, At, Bt) do { __builtin_amdgcn_s_setprio(1); _Pragma("unroll") for (int m = 0; m < 4; ++m) _Pragma("unroll") for (int n = 0; n < 2; ++n) _Pragma("unroll") for (int k = 0; k < 2; ++k) \
        acc[ai][bj][m][n] = __builtin_amdgcn_mfma_f32_16x16x32_bf16(Bt[n][k], At[m][k], acc[ai][bj][m][n], 0, 0, 0); __builtin_amdgcn_s_setprio(0); } while (0)
#define PG8_WAIT_V(n) asm volatile("s_waitcnt vmcnt(" #n ")" ::: "memory")
#define PG8_WAIT_L(n) asm volatile("s_waitcnt lgkmcnt(" #n ")" ::: "memory")
#define PG8_BAR __builtin_amdgcn_s_barrier()
#define PG8_SCHED __builtin_amdgcn_sched_barrier(0)
    Unit cur, nxt; int ui = 0;
    if (!S.next(0, cur)) return;
    f32x4 acc[2][2][4][2];
#pragma unroll
    for (int a = 0; a < 2; ++a)
#pragma unroll
        for (int b = 0; b < 2; ++b)
#pragma unroll
            for (int m = 0; m < 4; ++m)
#pragma unroll
                for (int n = 0; n < 2; ++n) acc[a][b][m][n] = (f32x4){0.f, 0.f, 0.f, 0.f};
    bf16x8 At[4][2], B0[2][2], B1[2][2];
    const size_t koffb = (size_t)g.K * 2;
    const char* cA = (const char*)g.A + (size_t)cur.pm * tstepA + (size_t)cur.ks * koffb; const char* cB = (const char*)g.Bt + (size_t)cur.pn * tstepB + (size_t)cur.ks * koffb;
    PG8_STAGE(PG8_SB(0, 0), cB, voffB); PG8_STAGE(PG8_SB(0, 1), cB + hstepB, voffB); PG8_STAGE(PG8_SA(0, 0), cA, voffA); PG8_STAGE(PG8_SA(0, 1), cA + hstepA, voffA);
    if (wr == 1) PG8_BAR;
    PG8_WAIT_V(2); PG8_BAR;
    PG8_STAGE(PG8_SB(1, 0), cB + kstep, voffB); PG8_STAGE(PG8_SA(1, 0), cA + kstep, voffA); PG8_STAGE(PG8_SB(1, 1), cB + hstepB + kstep, voffB);
    PG8_WAIT_V(6); PG8_BAR;
    for (;;) {
        const bool has_next = S.next(ui + 1, nxt);
        const char* nA = has_next ? (const char*)g.A + (size_t)nxt.pm * tstepA + (size_t)nxt.ks * koffb : cA; const char* nB = has_next ? (const char*)g.Bt + (size_t)nxt.pn * tstepB + (size_t)nxt.ks * koffb : cB;
        for (int t = 0; t < nt; t += 2) {
            const bool last = (t == nt - 2);
            const char* a1 = cA + (size_t)(t + 1) * kstep;
            const char* a2 = last ? nA : cA + (size_t)(t + 2) * kstep; const char* b2 = last ? nB : cB + (size_t)(t + 2) * kstep;
            const char* a3 = a2 + kstep; const char* b3 = b2 + kstep;
            PG8_LDB(B0, 0, 0); PG8_LDB(B1, 0, 1); PG8_SCHED; PG8_LDA(At, 0, 0); PG8_STAGE(PG8_SA(1, 1), a1 + hstepA, voffA);
            PG8_WAIT_V(8); PG8_WAIT_L(0); PG8_BAR; PG8_MMA(0, 0, At, B0); PG8_MMA(0, 1, At, B1); PG8_BAR; PG8_SCHED;
            PG8_LDA(At, 0, 1); PG8_STAGE(PG8_SB(0, 0), b2, voffB); PG8_STAGE(PG8_SB(0, 1), b2 + hstepB, voffB); PG8_STAGE(PG8_SA(0, 0), a2, voffA);
            PG8_WAIT_V(8); PG8_WAIT_L(0); PG8_BAR; PG8_MMA(1, 0, At, B0); PG8_MMA(1, 1, At, B1); PG8_BAR; PG8_SCHED;
            PG8_LDB(B0, 1, 0); PG8_LDB(B1, 1, 1); PG8_SCHED; PG8_LDA(At, 1, 0); PG8_STAGE(PG8_SA(0, 1), a2 + hstepA, voffA);
            PG8_WAIT_V(8); PG8_WAIT_L(0); PG8_BAR; PG8_MMA(0, 0, At, B0); PG8_MMA(0, 1, At, B1); PG8_BAR; PG8_SCHED;
            PG8_LDA(At, 1, 1); PG8_STAGE(PG8_SB(1, 0), b3, voffB); PG8_STAGE(PG8_SB(1, 1), b3 + hstepB, voffB); PG8_STAGE(PG8_SA(1, 0), a3, voffA);
            PG8_WAIT_V(8); PG8_WAIT_L(0); PG8_BAR; PG8_MMA(1, 0, At, B0); PG8_MMA(1, 1, At, B1); PG8_BAR; PG8_SCHED;
        }
        if (wr == 0) PG8_BAR;
        E(acc, cur, wr, wc, fr, fq);
        if (!has_next) break;
#pragma unroll
        for (int a = 0; a < 2; ++a)
#pragma unroll
            for (int b = 0; b < 2; ++b)
#pragma unroll
                for (int m = 0; m < 4; ++m)
#pragma unroll
                    for (int n = 0; n < 2; ++n) acc[a][b][m][n] = (f32x4){0.f, 0.f, 0.f, 0.f};
        cur = nxt; cA = nA; cB = nB; ++ui;
        if (wr == 1) PG8_BAR;
    }
    PG8_WAIT_V(0);
    PG8_BAR;
#undef PG8_SA
#undef PG8_SB
#undef PG8_STAGE
#undef PG8_LDA
#undef PG8_LDB
#undef PG8_MMA
#undef PG8_WAIT_V
#undef PG8_WAIT_L
#undef PG8_BAR
#undef PG8_SCHED
}
}

__device__ __forceinline__ void transpose_item(const float* W, int K, int N, int NP, bf16_t* WT, LAS float* scr, int item, int lane) {
    const int nblk = NP / 32, kb = item / nblk, nb = item % nblk, k0 = 64 * kb, n0 = 32 * nb;
    const int nn = n0 + (lane & 31); const bool ok = nn < N;
    float tv[32];
    const float* wp = W + (size_t)(k0 + (lane >> 5)) * N + nn;
#pragma unroll
    for (int i = 0; i < 32; ++i) tv[i] = ok ? __builtin_nontemporal_load(wp + (size_t)(2 * i) * N) : 0.f;
#pragma unroll
    for (int i = 0; i < 32; ++i) scr[(2 * i + (lane >> 5)) * 33 + (lane & 31)] = tv[i];
    asm volatile("s_waitcnt lgkmcnt(0)" ::: "memory");
    const int c = lane & 7;
#pragma unroll
    for (int j = 0; j < 4; ++j) { const int n = (lane >> 3) + 8 * j; const LAS float* s = scr + (8 * c) * 33 + n;
        u32x4 o; o.x = cvt_pk_bf16(s[0 * 33], s[1 * 33]); o.y = cvt_pk_bf16(s[2 * 33], s[3 * 33]); o.z = cvt_pk_bf16(s[4 * 33], s[5 * 33]); o.w = cvt_pk_bf16(s[6 * 33], s[7 * 33]);
        *(u32x4*)(WT + (size_t)(n0 + n) * K + k0 + 8 * c) = o; }
    asm volatile("s_waitcnt lgkmcnt(0)" ::: "memory");
}

__device__ __forceinline__ void norm_mod_row(const float* xrow, const float* nw, const float* mod, const float* bada, int sh_off, int sc_off, bf16_t* orow, int lane) {
    const f32x4* xr = (const f32x4*)xrow + lane;
    f32x4 v[4]; float s = 0.f;
#pragma unroll
    for (int j = 0; j < 4; ++j) { v[j] = xr[64 * j]; s += (v[j].x * v[j].x + v[j].y * v[j].y) + (v[j].z * v[j].z + v[j].w * v[j].w); }
    const float rstd = rsqrtf(wave_sum(s) * (1.f / DM) + EPS);
#pragma unroll
    for (int j = 0; j < 4; ++j) { const int col = 4 * lane + 256 * j;
        const f32x4 w = *(const f32x4*)(nw + col);
        const f32x4 sc = *(const f32x4*)(mod + sc_off + col) + *(const f32x4*)(bada + sc_off + col);
        const f32x4 sh = *(const f32x4*)(mod + sh_off + col) + *(const f32x4*)(bada + sh_off + col);
        const f32x4 y = v[j] * rstd * w * (sc + 1.f) + sh;
        u32x2 o; o.x = cvt_pk_bf16(y.x, y.y); o.y = cvt_pk_bf16(y.z, y.w);
        *(u32x2*)(orow + col) = o; }
}

constexpr int LROW = 72;
constexpr int L_QS = 0, L_KS = 9216, L_KT = 18432, L_P = 27648, L_VT = 36864, L_ST = 57600, L_VEC = 78336, L_RED = 79360;
constexpr int L_WA = 79872;


__device__ __forceinline__ bf16x8 frag(const LAS bf16_t* base, int row, int kofs) { return *(const LAS bf16x8*)(base + row * LROW + kofs); }
__device__ __forceinline__ f32x4 mma(bf16x8 a, bf16x8 b, f32x4 c) { return __builtin_amdgcn_mfma_f32_16x16x32_bf16(a, b, c, 0, 0, 0); }

__device__ __forceinline__ void stage_vT(const bf16_t* zr, int vcol0, LAS bf16_t* VT, int w, int l) {
    const u32x4* vp = (const u32x4*)(zr + vcol0 + 16 * w);
    const u32x4 a = vp[0], b = vp[1];
    LAS bf16_t* vt = VT + (16 * w) * LROW + l;
    vt[0 * LROW] = (bf16_t)(a.x & 0xffffu); vt[1 * LROW] = (bf16_t)(a.x >> 16); vt[2 * LROW] = (bf16_t)(a.y & 0xffffu); vt[3 * LROW] = (bf16_t)(a.y >> 16);
    vt[4 * LROW] = (bf16_t)(a.z & 0xffffu); vt[5 * LROW] = (bf16_t)(a.z >> 16); vt[6 * LROW] = (bf16_t)(a.w & 0xffffu); vt[7 * LROW] = (bf16_t)(a.w >> 16);
    vt[8 * LROW] = (bf16_t)(b.x & 0xffffu); vt[9 * LROW] = (bf16_t)(b.x >> 16); vt[10 * LROW] = (bf16_t)(b.y & 0xffffu); vt[11 * LROW] = (bf16_t)(b.y >> 16);
    vt[12 * LROW] = (bf16_t)(b.z & 0xffffu); vt[13 * LROW] = (bf16_t)(b.z >> 16); vt[14 * LROW] = (bf16_t)(b.w & 0xffffu); vt[15 * LROW] = (bf16_t)(b.w >> 16);
}

__device__ __forceinline__ void stage_weights(const Args& P, LAS unsigned char* lds, int type, int h, int tid) {
    LAS float* WA = (LAS float*)(lds + L_WA);
    if (type == 0) {
        for (int i = tid; i < 2 * 17 * 64; i += NTHR) { const int dir = i / (17 * 64), r = (i / 64) % 17, d = i & 63;
            WA[i] = (r < 16) ? P.w_alpha2[(dir * 16 + r) * 256 + h * 64 + d] : P.b_alpha[dir * 256 + h * 64 + d]; }
    } else {
        for (int i = tid; i < 9 * 128; i += NTHR) { const int tap = i >> 7, c = i & 127;
            WA[i] = P.conv_w[tap * 512 + (c < 64 ? h * 64 + c : 256 + h * 64 + (c - 64))]; }
    }
}
__device__ __forceinline__ void gla_gate(LAS unsigned char* lds, const bf16_t* zr, int dir, int w, int l, float (&b)[8], float (&bL)[8]) {
    const LAS float* WA = (const LAS float*)(lds + L_WA) + dir * 17 * 64 + 8 * w;
    const u32x4* rp = (const u32x4*)(zr + RA + dir * 16);
    float ra[16];
    { float t0[8], t1[8]; unpack8(rp[0], t0); unpack8(rp[1], t1);
#pragma unroll
      for (int i = 0; i < 8; ++i) { ra[i] = t0[i]; ra[8 + i] = t1[i]; } }
    float x[8];
    { const f32x4 c0 = *(const LAS f32x4*)(WA + 16 * 64), c1 = *(const LAS f32x4*)(WA + 16 * 64 + 4);
      x[0] = c0.x; x[1] = c0.y; x[2] = c0.z; x[3] = c0.w; x[4] = c1.x; x[5] = c1.y; x[6] = c1.z; x[7] = c1.w; }
#pragma unroll
    for (int r = 0; r < 16; ++r) { if ((r & 3) == 0) __builtin_amdgcn_sched_barrier(0);
        const f32x4 w0 = *(const LAS f32x4*)(WA + r * 64), w1 = *(const LAS f32x4*)(WA + r * 64 + 4);
        x[0] += ra[r] * w0.x; x[1] += ra[r] * w0.y; x[2] += ra[r] * w0.z; x[3] += ra[r] * w0.w; x[4] += ra[r] * w1.x; x[5] += ra[r] * w1.y; x[6] += ra[r] * w1.z; x[7] += ra[r] * w1.w; }
#pragma unroll
    for (int dd = 0; dd < 8; ++dd) {
        const float g = logsig(x[dd]) * (1.f / 16.f);
        b[dd] = scan_sum(g, l, dir);
        bL[dd] = __shfl(b[dd], dir ? 0 : 63);
    }
}

__device__ __forceinline__ void ml_gate(const Args& P, const bf16_t* zr, int dir, int h, int l, float& F, float& u, float& mloc) {
    const float ig = bflo((unsigned)zr[GB + (2 * dir) * 4 + h]) + P.b_mgate[(2 * dir) * 4 + h];
    const float fg = bflo((unsigned)zr[GB + (2 * dir + 1) * 4 + h]) + P.b_mgate[(2 * dir + 1) * 4 + h];
    const float lf = logsig(fg);
    F = scan_sum(lf, l, dir);
    u = ig - F;
    mloc = F + scan_max(u, l, dir);
}

template <bool WANT_Q>
__device__ __forceinline__ void ml_conv(LAS unsigned char* lds, const bf16_t* Z, int cgi, int n, bool sample, int h, int w, int l, float (&qv)[8], float (&kv)[8]) {
    const LAS float* WA = (const LAS float*)(lds + L_WA);
    float aq[8], ak[8];
#pragma unroll
    for (int i = 0; i < 8; ++i) { aq[i] = 0.f; ak[i] = 0.f; }
    const int chq = h * 64 + 8 * w;
#pragma unroll
    for (int dr = -1; dr <= 1; ++dr) {
        if (!sample && dr != 0) continue;
        const bool rok = sample ? (n + dr >= 0 && n + dr < 16) : true;
#pragma unroll
        for (int dc = -1; dc <= 1; ++dc) {
            const int col = l + dc;
            const bool cok = sample ? (col >= 0 && col < 64) : (64 * n + col >= 0 && 64 * n + col < 256);
            const bool ok = rok && cok;
            const long rr = (long)64 * (cgi + dr) + col;
            u32x4 zq = (u32x4){0u, 0u, 0u, 0u}, zk = (u32x4){0u, 0u, 0u, 0u};
            if (ok) { const bf16_t* zp = Z + (size_t)rr * LDZ; if (WANT_Q) zq = *(const u32x4*)(zp + QB + chq); zk = *(const u32x4*)(zp + KB + chq); }
            __builtin_amdgcn_sched_barrier(0);
            const LAS float* tp = WA + ((dr + 1) * 3 + (dc + 1)) * 128 + 8 * w;
            float fq[8], fk[8]; unpack8(zq, fq); unpack8(zk, fk);
            const f32x4 k0 = *(const LAS f32x4*)(tp + 64), k1 = *(const LAS f32x4*)(tp + 68);
            ak[0] += fk[0] * k0.x; ak[1] += fk[1] * k0.y; ak[2] += fk[2] * k0.z; ak[3] += fk[3] * k0.w; ak[4] += fk[4] * k1.x; ak[5] += fk[5] * k1.y; ak[6] += fk[6] * k1.z; ak[7] += fk[7] * k1.w;
            if (WANT_Q) { const f32x4 q0 = *(const LAS f32x4*)(tp), q1 = *(const LAS f32x4*)(tp + 4);
                aq[0] += fq[0] * q0.x; aq[1] += fq[1] * q0.y; aq[2] += fq[2] * q0.z; aq[3] += fq[3] * q0.w; aq[4] += fq[4] * q1.x; aq[5] += fq[5] * q1.y; aq[6] += fq[6] * q1.z; aq[7] += fq[7] * q1.w; }
        }
    }
#pragma unroll
    for (int i = 0; i < 8; ++i) { qv[i] = WANT_Q ? siluf_(aq[i]) * 0.125f : 0.f; kv[i] = siluf_(ak[i]); }
}

template <int type>
__device__ __forceinline__ void scan1_item(const Args& P, LAS unsigned char* lds, int cgi, int h) {
    const int tid = fresh_tid(), w = __builtin_amdgcn_readfirstlane(tid >> 6), l = tid & 63;
    const bf16_t* Z = (const bf16_t*)(P.ws + WS_Z);
    bf16_t* DS = (bf16_t*)(P.ws + WS_U); float* VEC = (float*)(P.ws + WS_VEC);
    LAS bf16_t* KT = (LAS bf16_t*)(lds + L_KT); LAS bf16_t* VT = (LAS bf16_t*)(lds + L_VT);
    const bf16_t* zr = Z + (size_t)(64 * cgi + l) * LDZ;
    const bool sample = cgi >= 64; const int n = sample ? (cgi & 15) : (cgi & 3);
    const int dt = w & 3, vh = w >> 2, lr = l & 15, lq = l >> 4;
    __syncthreads();
    float kf[8], qf[8];
    bf16_t* QK = (bf16_t*)(P.ws + WS_QK);
    if (type == 0) {
        stage_vT(zr, VA + h * 128, VT, w, l);
        unpack8(*(const u32x4*)(zr + KA + h * 64 + 8 * w), kf);
        unpack8(*(const u32x4*)(zr + QA + h * 64 + 8 * w), qf);
    } else {
        stage_vT(zr, VB + h * 128, VT, w, l);
        for (int i = tid; i < 16 * 64; i += NTHR) VT[(128 + (i >> 6)) * LROW + (i & 63)] = (i < 64) ? (bf16_t)0x3F80u : (bf16_t)0u;
        ml_conv<true>(lds, Z, cgi, n, sample, h, w, l, qf, kf);
        bf16_t* qk0 = QK + (size_t)(((96 + cgi) * 4 + h) * 2) * 8192;
        *(u32x4*)(qk0 + l * 64 + 8 * w) = pack8(qf);
        *(u32x4*)(qk0 + 4096 + l * 64 + 8 * w) = pack8(kf);
    }
    for (int dir = 0; dir < 2; ++dir) {
        const int slot = ((type * 96 + cgi) * 4 + h) * 2 + dir;
        if (type == 0) {
            float b[8], bL[8]; gla_gate(lds, zr, dir, w, l, b, bL);
#pragma unroll
            for (int dd = 0; dd < 8; ++dd) KT[(8 * w + dd) * LROW + l] = f2bf1(kf[dd] * __expf(bL[dd] - b[dd]));
            if (l == 0) {
#pragma unroll
                for (int dd = 0; dd < 8; ++dd) VEC[slot * 256 + 8 * w + dd] = __expf(bL[dd]);
            }
            float qt[8], kt[8];
#pragma unroll
            for (int dd = 0; dd < 8; ++dd) { qt[dd] = qf[dd] * __expf(b[dd]) * 0.125f; kt[dd] = kf[dd] * __expf(-b[dd]); }
            *(u32x4*)(QK + (size_t)slot * 8192 + l * 64 + 8 * w) = pack8(qt);
            *(u32x4*)(QK + (size_t)slot * 8192 + 4096 + l * 64 + 8 * w) = pack8(kt);
        } else {
            float F, u, mloc; ml_gate(P, zr, dir, h, l, F, u, mloc);
            const float FL = __shfl(F, dir ? 0 : 63), mlL = __shfl(mloc, dir ? 0 : 63);
            const float wk = __expf(FL + u - mlL);
#pragma unroll
            for (int dd = 0; dd < 8; ++dd) KT[(8 * w + dd) * LROW + l] = f2bf1(kf[dd] * wk);
            if (w == 0 && l == 0) { VEC[slot * 256 + 64] = FL; VEC[slot * 256 + 65] = mlL; }
            if (w == 0) { float* gv = (float*)(QK + (size_t)(((96 + cgi) * 4 + h) * 2 + 1) * 8192) + dir * 192; gv[l] = F; gv[64 + l] = u; gv[128 + l] = mloc; }
        }
        __syncthreads();
        const bf16x8 kb0 = frag(KT, 16 * dt + lr, lq * 8), kb1 = frag(KT, 16 * dt + lr, lq * 8 + 32);
        bf16_t* dsp = DS + (size_t)slot * 8192 + (16 * dt + lr) * 128 + lq * 4;
#pragma unroll
        for (int i = 0; i < 4; ++i) { const int vt = 4 * vh + i;
            f32x4 acc = (f32x4){0.f, 0.f, 0.f, 0.f};
            acc = mma(frag(VT, 16 * vt + lr, lq * 8), kb0, acc); acc = mma(frag(VT, 16 * vt + lr, lq * 8 + 32), kb1, acc);
            u32x2 o2; o2.x = cvt_pk_bf16(acc[0], acc[1]); o2.y = cvt_pk_bf16(acc[2], acc[3]); *(u32x2*)(dsp + 16 * vt) = o2; }
        if (type == 1 && vh == 1) {
            f32x4 acc = (f32x4){0.f, 0.f, 0.f, 0.f};
            acc = mma(frag(VT, 128 + lr, lq * 8), kb0, acc); acc = mma(frag(VT, 128 + lr, lq * 8 + 32), kb1, acc);
            if (lq == 0) VEC[slot * 256 + 16 * dt + lr] = acc[0];
        }
        __syncthreads();
    }
}


template <int NB>
__device__ __forceinline__ void prefix_unit(const Args& P, int unit) {
    const int tid = fresh_tid();
    int type, seq, h, dir, half;
    if (unit < 64) { half = unit & 1; const int c = unit >> 1; dir = c & 1; h = (c >> 1) & 3; seq = 16 + ((c >> 3) & 1); type = c >> 4; }
    else { const int u2 = unit - 64; half = u2 & 1; const int c = u2 >> 1; dir = c & 1; h = (c >> 1) & 3; seq = (c >> 3) & 15; type = c >> 7; }
    const bool sample = seq >= 16; const int NCH = sample ? 16 : 4; const int cgi0 = sample ? 64 + (seq - 16) * 16 : seq * 4; const int bs = sample ? seq - 16 : seq;
    const int v = tid & 127, dg = (tid >> 7) + 4 * half;
    const size_t sbase = (size_t)((bs * 2 + dir) * 4 + h);
    const bf16_t* DS = (const bf16_t*)(P.ws + WS_U); float* VEC = (float*)(P.ws + WS_VEC); bf16_t* STW = (bf16_t*)(P.ws + WS_STW);
    const bool nthr = (half == 0) && (tid < 64);
    float S[8]; float nst = 0.f, m_prev = 0.f;
    if (sample) {
        const float* s0 = (type == 0 ? P.st_gla : P.st_C) + sbase * 8192;
#pragma unroll
        for (int dd = 0; dd < 8; ++dd) S[dd] = s0[(8 * dg + dd) * 128 + v];
        if (type == 1) { nst = nthr ? P.st_n[sbase * 64 + tid] : 0.f; m_prev = P.st_m[sbase]; }
    } else {
#pragma unroll
        for (int dd = 0; dd < 8; ++dd) S[dd] = 0.f;
    }
    const int slot0 = ((type * 96 + cgi0) * 4 + h) * 2 + dir;
    for (int jb = 0; jb < NCH; jb += NB) {
        float D[NB][8], DEC[NB][8], SC[NB][3];
#pragma unroll
        for (int uu = 0; uu < NB; ++uu) {
            const int j = dir ? NCH - 1 - (jb + uu) : jb + uu; const int slot = slot0 + 8 * j;
            const bf16_t* dsj = DS + (size_t)slot * 8192; const float* vj = VEC + slot * 256;
#pragma unroll
            for (int dd = 0; dd < 8; ++dd) D[uu][dd] = bflo((unsigned)dsj[(8 * dg + dd) * 128 + v]);
            if (type == 0) { const f32x4 e0 = *(const f32x4*)(vj + 8 * dg), e1 = *(const f32x4*)(vj + 8 * dg + 4);
                DEC[uu][0] = e0.x; DEC[uu][1] = e0.y; DEC[uu][2] = e0.z; DEC[uu][3] = e0.w; DEC[uu][4] = e1.x; DEC[uu][5] = e1.y; DEC[uu][6] = e1.z; DEC[uu][7] = e1.w; }
            else { SC[uu][0] = vj[64]; SC[uu][1] = vj[65]; SC[uu][2] = nthr ? vj[tid] : 0.f; }
        }
#pragma unroll
        for (int uu = 0; uu < NB; ++uu) {
            const int j = dir ? NCH - 1 - (jb + uu) : jb + uu; const int slot = slot0 + 8 * j;
            *(u32x4*)(STW + (size_t)slot * 8192 + v * 64 + 8 * dg) = pack8(S);
            float a = 1.f, bsc = 1.f;
            if (type == 1) {
                if (nthr) VEC[slot * 256 + 128 + tid] = nst;
                if (half == 0 && tid == 0) VEC[slot * 256 + 66] = m_prev;
                const float FLj = SC[uu][0], mlj = SC[uu][1]; const float m_new = fmaxf(FLj + m_prev, mlj);
                a = __expf(FLj + m_prev - m_new); bsc = __expf(mlj - m_new); m_prev = m_new;
                nst = a * nst + bsc * SC[uu][2];
            }
#pragma unroll
            for (int dd = 0; dd < 8; ++dd) S[dd] = ((type == 0) ? DEC[uu][dd] : a) * S[dd] + bsc * D[uu][dd];
        }
    }
    if (!sample) {
        float* og = P.out + (size_t)NTOK * DM + (type == 0 ? 0 : 1048576) + sbase * 8192;
#pragma unroll
        for (int dd = 0; dd < 8; ++dd) og[(8 * dg + dd) * 128 + v] = S[dd];
        if (type == 1) {
            if (nthr) P.out[(size_t)NTOK * DM + 2097152 + sbase * 64 + tid] = nst;
            if (half == 0 && tid == 0) P.out[(size_t)NTOK * DM + 2097152 + 8192 + sbase] = m_prev;
        }
    }
}

template <int type> struct S2A { u32x4 va, vb, q, k; };
template <int type> struct S2D { u32x4 q, k; float F, u, mloc, m_prev; const float* np; bf16x8 sf[4][2]; };

template <int type>
__device__ __forceinline__ void s2_loadA(const Args& P, int cgi, int h, int w, int l, int tt, int vh, int lr, int lq, S2A<type>& a) {
    const bf16_t* Z = (const bf16_t*)(P.ws + WS_Z);
    const bf16_t* zr = Z + (size_t)(64 * cgi + l) * LDZ;
    const u32x4* vp = (const u32x4*)(zr + (type == 0 ? VA : VB) + h * 128 + 16 * w);
    a.va = vp[0]; a.vb = vp[1];
    if (type == 1) { const bf16_t* qk0 = (const bf16_t*)(P.ws + WS_QK) + (size_t)(((96 + cgi) * 4 + h) * 2) * 8192;
        a.q = *(const u32x4*)(qk0 + l * 64 + 8 * w); a.k = *(const u32x4*)(qk0 + 4096 + l * 64 + 8 * w); }
}
template <int type>
__device__ __forceinline__ void s2_loadD(const Args& P, int cgi, int h, int dir, int w, int l, int vh, int lr, int lq, S2D<type>& d) {
    const int slot = ((type * 96 + cgi) * 4 + h) * 2 + dir;
    const bf16_t* stg = (const bf16_t*)(P.ws + WS_STW) + (size_t)slot * 8192;
#pragma unroll
    for (int i = 0; i < 4; ++i) { d.sf[i][0] = *(const bf16x8*)(stg + (16 * (4 * vh + i) + lr) * 64 + lq * 8); d.sf[i][1] = *(const bf16x8*)(stg + (16 * (4 * vh + i) + lr) * 64 + lq * 8 + 32); }
    const bf16_t* QK = (const bf16_t*)(P.ws + WS_QK);
    if (type == 0) { d.q = *(const u32x4*)(QK + (size_t)slot * 8192 + l * 64 + 8 * w); d.k = *(const u32x4*)(QK + (size_t)slot * 8192 + 4096 + l * 64 + 8 * w); }
    else {
        const float* VEC = (const float*)(P.ws + WS_VEC);
        const float* gv = (const float*)(QK + (size_t)(((96 + cgi) * 4 + h) * 2 + 1) * 8192) + dir * 192;
        d.F = gv[l]; d.u = gv[64 + l]; d.mloc = gv[128 + l]; d.m_prev = VEC[slot * 256 + 66];
        d.np = VEC + slot * 256 + 128 + lq * 8;
    }
}
template <int type>
__device__ __forceinline__ void s2_dir(LAS unsigned char* lds, const S2D<type>& d, int dir, int w, int l, int tt, int vh, int lr, int lq, const f32x4 (&qk)[2], f32x4 (&hs)[4]) {
    LAS bf16_t* QS = (LAS bf16_t*)(lds + L_QS); LAS bf16_t* KS = (LAS bf16_t*)(lds + L_KS); LAS bf16_t* PP = (LAS bf16_t*)(lds + L_P); LAS bf16_t* VT = (LAS bf16_t*)(lds + L_VT);
    LAS float* vecA = (LAS float*)(lds + L_VEC); LAS float* vecU = vecA + 64; LAS float* vecWI = vecA + 128; LAS float* vecMT = vecA + 192;
    const int st_ = w >> 1;
    f32x4 nn[4] = {(f32x4){0.f, 0.f, 0.f, 0.f}, (f32x4){0.f, 0.f, 0.f, 0.f}, (f32x4){0.f, 0.f, 0.f, 0.f}, (f32x4){0.f, 0.f, 0.f, 0.f}};
    if (type == 1) { nn[0] = *(const f32x4*)(d.np); nn[1] = *(const f32x4*)(d.np + 4); nn[2] = *(const f32x4*)(d.np + 32); nn[3] = *(const f32x4*)(d.np + 36); }
    if (type == 0) {
        *(LAS u32x4*)(QS + l * LROW + 8 * w) = d.q;
        *(LAS u32x4*)(KS + l * LROW + 8 * w) = d.k;
    } else {
        const float mt = fmaxf(d.F + d.m_prev, d.mloc);
        if (w == 0) { vecA[l] = d.F - mt; vecU[l] = d.u; vecWI[l] = __expf(d.F + d.m_prev - mt); vecMT[l] = mt; }
    }
    __syncthreads();
#pragma unroll
    for (int i = 0; i < 2; ++i) { const int tt2 = (w & 1) * 2 + i; const int s0 = 16 * st_ + 4 * lq, t = 16 * tt2 + lr;
        f32x4 a;
        if (type == 0) {
            a = (f32x4){0.f, 0.f, 0.f, 0.f};
            a = mma(frag(KS, 16 * st_ + lr, lq * 8), frag(QS, 16 * tt2 + lr, lq * 8), a);
            a = mma(frag(KS, 16 * st_ + lr, lq * 8 + 32), frag(QS, 16 * tt2 + lr, lq * 8 + 32), a);
        } else {
            const float At = vecA[t]; const f32x4 u4 = *(const LAS f32x4*)(vecU + s0);
#pragma unroll
            for (int j = 0; j < 4; ++j) a[j] = qk[i][j] * __expf(At + u4[j]);
        }
        float p[4];
#pragma unroll
        for (int j = 0; j < 4; ++j) { const bool keep = dir ? (s0 + j >= t) : (s0 + j <= t); p[j] = keep ? a[j] : 0.f; }
        u32x2 o; o.x = cvt_pk_bf16(p[0], p[1]); o.y = cvt_pk_bf16(p[2], p[3]);
        *(LAS u32x2*)(PP + t * LROW + s0) = o; }
    __syncthreads();
    const bf16x8 pb0 = frag(PP, 16 * tt + lr, lq * 8), pb1 = frag(PP, 16 * tt + lr, lq * 8 + 32);
    const bf16x8 qb0 = frag(QS, 16 * tt + lr, lq * 8), qb1 = frag(QS, 16 * tt + lr, lq * 8 + 32);
    if (type == 0) {
#pragma unroll
        for (int i = 0; i < 4; ++i) { const int vt = 4 * vh + i;
            f32x4 a = hs[i];
            a = mma(frag(VT, 16 * vt + lr, lq * 8), pb0, a); a = mma(frag(VT, 16 * vt + lr, lq * 8 + 32), pb1, a);
            a = mma(d.sf[i][0], qb0, a); a = mma(d.sf[i][1], qb1, a);
            hs[i] = a; }
    } else {
        const int t = 16 * tt + lr; const float wi_t = vecWI[t], mt_t = vecMT[t];
        f32x4 aI = (f32x4){0.f, 0.f, 0.f, 0.f}, aS = (f32x4){0.f, 0.f, 0.f, 0.f};
        {
            const short one = (lr == 0) ? (short)0x3F80 : (short)0;
            const bf16x8 onesf = (bf16x8){one, one, one, one, one, one, one, one};
            aI = mma(onesf, pb0, aI); aI = mma(onesf, pb1, aI);
            const float z = (lr == 0) ? 1.f : 0.f;
            float n0[8] = {nn[0].x * z, nn[0].y * z, nn[0].z * z, nn[0].w * z, nn[1].x * z, nn[1].y * z, nn[1].z * z, nn[1].w * z};
            float n1[8] = {nn[2].x * z, nn[2].y * z, nn[2].z * z, nn[2].w * z, nn[3].x * z, nn[3].y * z, nn[3].z * z, nn[3].w * z};
            const u32x4 p0 = pack8(n0), p1 = pack8(n1);
            aS = mma(__builtin_bit_cast(bf16x8, p0), qb0, aS); aS = mma(__builtin_bit_cast(bf16x8, p1), qb1, aS);
        }
        float den = aI[0] + wi_t * aS[0];
        den = __shfl(den, lr);
        const float inv = 1.f / fmaxf(fabsf(den), __expf(-mt_t));
#pragma unroll
        for (int i = 0; i < 4; ++i) { const int vt = 4 * vh + i;
            f32x4 bI = (f32x4){0.f, 0.f, 0.f, 0.f}, bS = (f32x4){0.f, 0.f, 0.f, 0.f};
            bI = mma(frag(VT, 16 * vt + lr, lq * 8), pb0, bI); bI = mma(frag(VT, 16 * vt + lr, lq * 8 + 32), pb1, bI);
            bS = mma(d.sf[i][0], qb0, bS); bS = mma(d.sf[i][1], qb1, bS);
            hs[i] += (bI + wi_t * bS) * inv; }
    }
    __syncthreads();
}

template <int type>
__device__ __forceinline__ void scan2_loop(const Args& P, LAS unsigned char* lds, int h, int cq, int cstep, int cend) {
    const int tid = fresh_tid(), w = __builtin_amdgcn_readfirstlane(tid >> 6), l = tid & 63;
    bf16_t* MIX = (bf16_t*)(P.ws + WS_MIX);
    LAS bf16_t* QS = (LAS bf16_t*)(lds + L_QS); LAS bf16_t* KS = (LAS bf16_t*)(lds + L_KS); LAS bf16_t* VT = (LAS bf16_t*)(lds + L_VT);
    LAS float* RED = (LAS float*)(lds + L_RED);
    const int tt = w & 3, vh = w >> 2, lr = l & 15, lq = l >> 4, st_ = w >> 1;
    f32x4 w4v[4];
#pragma unroll
    for (int i = 0; i < 4; ++i) w4v[i] = *(const f32x4*)((type == 0 ? P.gnorm_a_w : P.gnorm_b_w) + h * 128 + 16 * (4 * vh + i) + 4 * lq);
    S2A<type> A; S2D<type> D0;
    s2_loadA<type>(P, cq, h, w, l, tt, vh, lr, lq, A);
    s2_loadD<type>(P, cq, h, 0, w, l, vh, lr, lq, D0);
    for (int cgi = cq; cgi < cend; cgi += cstep) {
        const bool has_next = (cgi + cstep) < cend;
        S2D<type> D1; s2_loadD<type>(P, cgi, h, 1, w, l, vh, lr, lq, D1);
        u32x2 gzv[4];
        { const bf16_t* Z = (const bf16_t*)(P.ws + WS_Z); const size_t rowz = (size_t)64 * cgi + 16 * tt + lr;
#pragma unroll
          for (int i = 0; i < 4; ++i) gzv[i] = *(const u32x2*)(Z + rowz * LDZ + (type == 0 ? GA : OB) + h * 128 + 16 * (4 * vh + i) + 4 * lq); }
        S2A<type> An;
        if (has_next) s2_loadA<type>(P, cgi + cstep, h, w, l, tt, vh, lr, lq, An);
        __syncthreads();
        {
            LAS bf16_t* vt = VT + (16 * w) * LROW + l;
            const u32x4 a = A.va, b = A.vb;
            vt[0 * LROW] = (bf16_t)(a.x & 0xffffu); vt[1 * LROW] = (bf16_t)(a.x >> 16); vt[2 * LROW] = (bf16_t)(a.y & 0xffffu); vt[3 * LROW] = (bf16_t)(a.y >> 16);
            vt[4 * LROW] = (bf16_t)(a.z & 0xffffu); vt[5 * LROW] = (bf16_t)(a.z >> 16); vt[6 * LROW] = (bf16_t)(a.w & 0xffffu); vt[7 * LROW] = (bf16_t)(a.w >> 16);
            vt[8 * LROW] = (bf16_t)(b.x & 0xffffu); vt[9 * LROW] = (bf16_t)(b.x >> 16); vt[10 * LROW] = (bf16_t)(b.y & 0xffffu); vt[11 * LROW] = (bf16_t)(b.y >> 16);
            vt[12 * LROW] = (bf16_t)(b.z & 0xffffu); vt[13 * LROW] = (bf16_t)(b.z >> 16); vt[14 * LROW] = (bf16_t)(b.w & 0xffffu); vt[15 * LROW] = (bf16_t)(b.w >> 16);
        }
        f32x4 qk[2] = {(f32x4){0.f, 0.f, 0.f, 0.f}, (f32x4){0.f, 0.f, 0.f, 0.f}};
        if (type == 1) {
            *(LAS u32x4*)(QS + l * LROW + 8 * w) = A.q;
            *(LAS u32x4*)(KS + l * LROW + 8 * w) = A.k;
            __syncthreads();
#pragma unroll
            for (int i = 0; i < 2; ++i) { const int tt2 = (w & 1) * 2 + i;
                f32x4 a = (f32x4){0.f, 0.f, 0.f, 0.f};
                a = mma(frag(KS, 16 * st_ + lr, lq * 8), frag(QS, 16 * tt2 + lr, lq * 8), a);
                a = mma(frag(KS, 16 * st_ + lr, lq * 8 + 32), frag(QS, 16 * tt2 + lr, lq * 8 + 32), a);
                qk[i] = a; }
        }
        f32x4 hs[4];
#pragma unroll
        for (int i = 0; i < 4; ++i) hs[i] = (f32x4){0.f, 0.f, 0.f, 0.f};
        s2_dir<type>(lds, D0, 0, w, l, tt, vh, lr, lq, qk, hs);
        if (has_next) s2_loadD<type>(P, cgi + cstep, h, 0, w, l, vh, lr, lq, D0);
        s2_dir<type>(lds, D1, 1, w, l, tt, vh, lr, lq, qk, hs);
        float ssq = 0.f;
#pragma unroll
        for (int i = 0; i < 4; ++i) ssq += (hs[i][0] * hs[i][0] + hs[i][1] * hs[i][1]) + (hs[i][2] * hs[i][2] + hs[i][3] * hs[i][3]);
        ssq += __shfl_xor(ssq, 16); ssq += __shfl_xor(ssq, 32);
        if (lq == 0) RED[vh * 64 + 16 * tt + lr] = ssq;
        __syncthreads();
        const float tot = RED[16 * tt + lr] + RED[64 + 16 * tt + lr];
        const float rstd = rsqrtf(tot * (1.f / 128.f) + EPS);
        const size_t rowt = (size_t)64 * cgi + 16 * tt + lr;
#pragma unroll
        for (int i = 0; i < 4; ++i) { const int col = h * 128 + 16 * (4 * vh + i) + 4 * lq;
            const u32x2 gz = gzv[i];
            const f32x4 w4 = w4v[i];
            float g[4] = {bflo(gz.x), bfhi(gz.x), bflo(gz.y), bfhi(gz.y)};
            float o[4];
#pragma unroll
            for (int j = 0; j < 4; ++j) o[j] = hs[i][j] * rstd * w4[j] * (type == 0 ? siluf_(g[j]) : sigmoidf_(g[j]));
            u32x2 ov; ov.x = cvt_pk_bf16(o[0], o[1]); ov.y = cvt_pk_bf16(o[2], o[3]);
            *(u32x2*)(MIX + rowt * DM + type * 512 + col) = ov; }
        if (has_next) A = An;
    }
}

__global__ void __launch_bounds__(NTHR, 2) fwd_megakernel(Args P) {
    extern __shared__ __attribute__((aligned(16))) unsigned char lds_raw[];
    LAS unsigned char* lds = (LAS unsigned char*)lds_raw;
    const int tid = threadIdx.x, lane = tid & 63, wave = __builtin_amdgcn_readfirstlane(tid >> 6);
    const int G = gridDim.x, bx = blockIdx.x;
    const int gw = bx * NWAVES + wave, NGW = G * NWAVES;
    unsigned char* ws = P.ws;
    float* MOD = (float*)(ws + WS_MOD);
    bf16_t* WIN = (bf16_t*)(ws + WS_WIN); bf16_t* WOUT = (bf16_t*)(ws + WS_WOUT); bf16_t* W1 = (bf16_t*)(ws + WS_W1); bf16_t* W2 = (bf16_t*)(ws + WS_W2);
    bf16_t* XN = (bf16_t*)(ws + WS_XN); bf16_t* Z = (bf16_t*)(ws + WS_Z); bf16_t* MIX = (bf16_t*)(ws + WS_MIX);
    float* X1 = (float*)(ws + WS_X1); float* X2B = (float*)(ws + WS_X2B); bf16_t* U = (bf16_t*)(ws + WS_U);
    volatile LAS unsigned* bst = (volatile LAS unsigned*)(lds + 131072);
    if (tid < 2) bst[tid] = 0u;
    __syncthreads();
    const XcdBarrier bar = xcd_barrier_post((unsigned*)(ws + WS_BAR), bst);

    {
        LAS float* scr = (LAS float*)(lds + wave * 8448);
        LAS float* sc = (LAS float*)(lds + 8 * 8448);
        for (int i = tid; i < 3 * DM; i += NTHR) { const int c = i >> 10, k = i & 1023; const float v = (c == 0) ? P.c_ctx[k] : P.c[(c - 1) * DM + k]; sc[i] = v / (1.f + __expf(-v)); }
        __syncthreads();
        for (int it = gw; it < 1536; it += NGW) {
            const int cb = it >> 4, kc = it & 15, col = cb * 64 + lane;
            const float* wp = P.w_ada + (size_t)(kc * 64) * 6144 + col;
            float a0 = 0.f, a1 = 0.f, a2 = 0.f;
#pragma unroll 16
            for (int k = 0; k < 64; ++k) { const float wv = __builtin_nontemporal_load(wp + (size_t)k * 6144); a0 += sc[kc * 64 + k] * wv; a1 += sc[DM + kc * 64 + k] * wv; a2 += sc[2 * DM + kc * 64 + k] * wv; }
            unsafeAtomicAdd(MOD + col, a0); unsafeAtomicAdd(MOD + 6144 + col, a1); unsafeAtomicAdd(MOD + 2 * 6144 + col, a2);
        }
        constexpr int I_IN = (DM / 64) * (LDZ / 32), I_O = (DM / 64) * (DM / 32), I_1 = (DM / 64) * (DFF / 32), I_2 = (DFF / 64) * (DM / 32);
        const bool ff_later = (G > 96 + 32);
        for (int it = gw; it < I_IN + I_O + (ff_later ? 0 : I_1 + I_2); it += NGW) {
            int r = it;
            if (r < I_IN) { transpose_item(P.w_in, DM, DIN, LDZ, WIN, scr, r, lane); continue; } r -= I_IN;
            if (r < I_O) { transpose_item(P.w_out, DM, DM, DM, WOUT, scr, r, lane); continue; } r -= I_O;
            if (r < I_1) { transpose_item(P.w_ff1, DM, DFF, DFF, W1, scr, r, lane); continue; } r -= I_1;
            transpose_item(P.w_ff2, DFF, DM, DM, W2, scr, r, lane);
        }
    }
    xcd_barrier(bar);
    if (tid == 0) { unsigned okc = 1u; for (int j = 0; j < 8; ++j) okc &= (xb_ld((unsigned*)(ws + WS_BAR) + XB_XCNT(j)) == 32u) ? 1u : 0u; bst[4] = (G == 256) ? okc : 0u; }
    __syncthreads();
    const bool aff = (G == 256);
    const bool realx = __builtin_amdgcn_readfirstlane((int)bst[4]) != 0;
    const int ax = realx ? __builtin_amdgcn_readfirstlane((int)bst[3]) : (bx & 7), ali = realx ? __builtin_amdgcn_readfirstlane((int)bst[2]) : (bx >> 3);
    const bool lseam = aff && realx;
#define SEAM_LOCAL() do { if (lseam) xcd_local_barrier(bar); else xcd_barrier(bar); } while (0)
    const int vbx = aff ? (ax + 8 * ali) : bx;
    const int rm0 = aff ? 768 * ax + ali * NWAVES + wave : gw, rmstep = aff ? 256 : NGW, rmend = aff ? 768 * ax + 768 : NTOK;
    for (int rep_p1 = 0; rep_p1 < ((DUP & 2) ? 2 : 1); ++rep_p1) {
    if (DUP & 512) { for (int q = 0; q < 8; ++q) xcd_barrier(bar); }
    { const int lane = fresh_tid() & 63;
    for (int m = rm0; m < rmend; m += rmstep) {
        const float* xr = m < NPR ? P.x_prompt + (size_t)m * DM : P.x_sample + (size_t)(m - NPR) * DM;
        const int cond = m < NPR ? 0 : 1 + ((m - NPR) >> 10);
        norm_mod_row(xr, P.norm1_w, MOD + cond * 6144, P.b_ada, 0, 1024, XN + (size_t)m * DM, lane);
    } }
    SEAM_LOCAL();
    }
    for (int rep_p2 = 0; rep_p2 < ((DUP & 4) ? 2 : 1); ++rep_p2) {
    {
        pg8::Gemm g{XN, WIN, DM, DM, DM}; pg8::Order S; S.init(NTOK, LDZ, 1, G, vbx);
        pg8::EpiBf16<0> E{Z, LDZ};
        pg8::gemm_phase(lds, g, S, E);
        constexpr int NU1 = (NTOK / 256) * (LDZ / 256);
        const int nbusy = NU1 - G;
        if (false && rep_p2 == 0 && nbusy >= 0 && nbusy < G && bx >= nbusy) {
            __syncthreads();
            LAS float* scr = (LAS float*)(lds + wave * 8448);
            constexpr int I_O = (DM / 64) * (DM / 32), I_1 = (DM / 64) * (DFF / 32), I_2 = (DFF / 64) * (DM / 32);
            const int lane2 = fresh_tid() & 63;
            for (int it = (bx - nbusy) * NWAVES + wave; it < I_O + I_1 + I_2; it += (G - nbusy) * NWAVES) {
                int r = it;
                if (r < I_O) { transpose_item(P.w_out, DM, DM, DM, WOUT, scr, r, lane2); continue; } r -= I_O;
                if (r < I_1) { transpose_item(P.w_ff1, DM, DFF, DFF, W1, scr, r, lane2); continue; } r -= I_1;
                transpose_item(P.w_ff2, DFF, DM, DM, W2, scr, r, lane2);
            }
        }
    }
    xcd_barrier(bar);
    }
    for (int rep_p3 = 0; rep_p3 < ((DUP & 8) ? 2 : 1); ++rep_p3) {
    {
        const int type = aff ? ((ali >> 2) & 1) : ((bx >> 2) & 1), h = aff ? (ali & 3) : (bx & 3);
        const int cq = aff ? 12 * ax + (ali >> 3) : (bx >> 3), cstep = aff ? 4 : (G >> 3), cend = aff ? 12 * ax + 12 : 96;
        __syncthreads();
        stage_weights(P, lds, type, h, fresh_tid());
        __syncthreads();
        if ((G & 7) == 0) { for (int cgi = cq; cgi < cend; cgi += cstep) { if (type == 0) scan1_item<0>(P, lds, cgi, h); else scan1_item<1>(P, lds, cgi, h); } }
    }
    xcd_barrier(bar);
    }
    for (int rep_p4 = 0; rep_p4 < ((DUP & 16) ? 2 : 1); ++rep_p4) {
    if (aff) {
        if (ax < 5) { for (int j = 0; j < 3; ++j) { const int k = ali * 3 + j, seq = 3 * ax + (k >> 5), r = k & 31; prefix_unit<4>(P, 64 + ((r & 15) | (seq << 4) | ((r >> 4) << 8))); } }
        else { const int idx = (ax - 5) * 32 + ali; if (idx < 32) prefix_unit<4>(P, 64 + ((idx & 15) | (15 << 4) | ((idx >> 4) << 8))); else prefix_unit<8>(P, idx - 32); }
    }
    else if (bx < 64 && G > 64) prefix_unit<8>(P, bx);
    else if (G > 64) { for (int u = 64 + (bx - 64); u < 576; u += G - 64) prefix_unit<4>(P, u); }
    else { for (int u = bx; u < 576; u += G) prefix_unit<4>(P, u); }
    xcd_barrier(bar);
    {
        const int type = aff ? ((ali >> 2) & 1) : ((bx >> 2) & 1), h = aff ? (ali & 3) : (bx & 3);
        const int cq = aff ? 12 * ax + (ali >> 3) : (bx >> 3), cstep = aff ? 4 : (G >> 3), cend = aff ? 12 * ax + 12 : 96;
        if ((G & 7) == 0) { if (type == 0) scan2_loop<0>(P, lds, h, cq, cstep, cend); else scan2_loop<1>(P, lds, h, cq, cstep, cend); }
    }
    SEAM_LOCAL();
    }
    for (int rep_p5 = 0; rep_p5 < ((DUP & 32) ? 2 : 1); ++rep_p5) {
    {
        pg8::Gemm g{MIX, WOUT, DM, DM, DM}; pg8::Order S; S.init(NTOK, DM, 1, G, vbx);
        pg8::EpiRes E{P.x_prompt, P.x_sample, X1, X1, MOD, P.b_ada, 2048, 0};
        pg8::gemm_phase(lds, g, S, E);
        const bool p5_idle = aff ? (ali >= 12) : (bx >= 96);
        const int p5_idx = aff ? (ali - 12) + 20 * ax : (bx - 96);
        if (G > 96 + 32 && p5_idle) {
            LAS float* scr = (LAS float*)(lds + wave * 8448);
            constexpr int I_1 = (DM / 64) * (DFF / 32), I_2 = (DFF / 64) * (DM / 32);
            const int lane2 = fresh_tid() & 63;
            for (int it = p5_idx * NWAVES + wave; it < I_1 + I_2; it += (G - 96) * NWAVES) {
                if (it < I_1) transpose_item(P.w_ff1, DM, DFF, DFF, W1, scr, it, lane2);
                else transpose_item(P.w_ff2, DFF, DM, DM, W2, scr, it - I_1, lane2);
            }
        }
    }
    SEAM_LOCAL();
    }
    for (int rep_p6 = 0; rep_p6 < ((DUP & 64) ? 2 : 1); ++rep_p6) {
    { const int lane = fresh_tid() & 63;
    for (int m = rm0; m < rmend; m += rmstep) {
        const int cond = m < NPR ? 0 : 1 + ((m - NPR) >> 10);
        norm_mod_row(X1 + (size_t)m * DM, P.norm2_w, MOD + cond * 6144, P.b_ada, 3072, 4096, XN + (size_t)m * DM, lane);
    } }
    xcd_barrier(bar);
    }
    for (int rep_p7 = 0; rep_p7 < ((DUP & 128) ? 2 : 1); ++rep_p7) {
    {
        pg8::Gemm g{XN, W1, DM, DM, DM}; pg8::Order S; S.init(NTOK, DFF, 1, G, vbx);
        pg8::EpiBf16<1> E{U, DFF};
        pg8::gemm_phase(lds, g, S, E);
    }
    SEAM_LOCAL();
    }
    {
        pg8::Gemm g{U, W2, DFF, DFF, DFF / 2}; pg8::Order S; S.init(NTOK, DM, 2, G, vbx);
        pg8::EpiRes E{nullptr, nullptr, X1, X2B, MOD, P.b_ada, 5120, 1};
        pg8::gemm_phase(lds, g, S, E);
    }
    SEAM_LOCAL();
    { const int lane = fresh_tid() & 63;
    for (int m = rm0; m < rmend; m += rmstep) {
        const f32x4* xa = (const f32x4*)(X1 + (size_t)m * DM) + lane; const f32x4* xb = (const f32x4*)(X2B + (size_t)m * DM) + lane;
        f32x4 v[4]; float s = 0.f;
#pragma unroll
        for (int j = 0; j < 4; ++j) { v[j] = xa[64 * j] + xb[64 * j]; s += (v[j].x * v[j].x + v[j].y * v[j].y) + (v[j].z * v[j].z + v[j].w * v[j].w); }
        const float rstd = rsqrtf(wave_sum(s) * (1.f / DM) + EPS);
        f32x4* o = (f32x4*)(P.out + (size_t)m * DM) + lane;
#pragma unroll
        for (int j = 0; j < 4; ++j) o[64 * j] = v[j] * rstd * *(const f32x4*)(P.final_norm_w + 4 * lane + 256 * j);
    } }
}

extern "C" void kernel_launch(void* const* d_in, const int* in_sizes, int n_in, void* d_out, int out_size, void* d_ws, size_t ws_size, hipStream_t stream) {
    static int grid = 0;
    if (grid == 0) {
        int dev = 0, cus = 0, per_cu = 0;
        hipGetDevice(&dev);
        hipDeviceGetAttribute(&cus, hipDeviceAttributeMultiprocessorCount, dev);
        if (hipFuncSetAttribute((const void*)fwd_megakernel, hipFuncAttributeMaxDynamicSharedMemorySize, LDS_BYTES) != hipSuccess) { fprintf(stderr, "hipFuncSetAttribute failed\n"); grid = -1; return; }
        if (hipOccupancyMaxActiveBlocksPerMultiprocessor(&per_cu, (const void*)fwd_megakernel, NTHR, LDS_BYTES) != hipSuccess || per_cu < 1) { fprintf(stderr, "occupancy query: %d blocks per CU\n", per_cu); grid = -1; return; }
        grid = cus;
        if (n_in != 23 || ws_size < WS_END) { fprintf(stderr, "unexpected inputs / workspace\n"); grid = -1; return; }
    }
    if (grid < 0) return;
    (void)hipMemsetAsync((char*)d_ws + WS_MOD, 0, WS_ZERO_BYTES, stream);
    Args a{};
    const float* const* in = (const float* const*)d_in;
    a.x_prompt = in[0]; a.x_sample = in[1]; a.c = in[2]; a.st_gla = in[3]; a.st_C = in[4]; a.st_n = in[5]; a.st_m = in[6]; a.c_ctx = in[7];
    a.w_ada = in[8]; a.b_ada = in[9]; a.norm1_w = in[10]; a.norm2_w = in[11]; a.w_in = in[12]; a.w_alpha2 = in[13]; a.b_alpha = in[14]; a.b_mgate = in[15];
    a.conv_w = in[16]; a.gnorm_a_w = in[17]; a.gnorm_b_w = in[18]; a.w_out = in[19]; a.w_ff1 = in[20]; a.w_ff2 = in[21]; a.final_norm_w = in[22];
    a.out = (float*)d_out; a.ws = (unsigned char*)d_ws;
    void* args[] = {&a};
    hipError_t e = hipLaunchCooperativeKernel((const void*)fwd_megakernel, dim3(grid), dim3(NTHR), args, LDS_BYTES, stream);
    if (e != hipSuccess) fprintf(stderr, "cooperative launch failed: %s (grid %d)\n", hipGetErrorString(e), grid);
}
```

```cpp
#include <hip/hip_runtime.h>
#include <hip/hip_cooperative_groups.h>
#include <cstdio>
#include <cstdint>
namespace cg = cooperative_groups;

#define LAS __attribute__((address_space(3)))
typedef unsigned short bf16_t;
typedef short bf16x8 __attribute__((ext_vector_type(8)));
typedef float f32x4 __attribute__((ext_vector_type(4)));
typedef unsigned u32x4 __attribute__((ext_vector_type(4)));
typedef unsigned u32x2 __attribute__((ext_vector_type(2)));

constexpr int DM = 1024, NTOK = 6144, NPR = 4096, DIN = 3120, LDZ = 3328, DFF = 4096;
constexpr int QA = 0, KA = 256, VA = 512, GA = 1024, RA = 1536, QB = 1568, KB = 1824, VB = 2080, OB = 2592, GB = 3104;
constexpr int NWAVES = 8, NTHR = 512;
constexpr float EPS = 1e-6f;

constexpr size_t WS_MOD = 0;
constexpr size_t WS_BAR = 73728;
constexpr size_t WS_ZERO_BYTES = 73728 + 5504 * 4;
constexpr size_t WS_WIN = 131072;
constexpr size_t WS_WOUT = WS_WIN + (size_t)LDZ * DM * 2;
constexpr size_t WS_W1 = WS_WOUT + (size_t)DM * DM * 2;
constexpr size_t WS_W2 = WS_W1 + (size_t)DFF * DM * 2;
constexpr size_t WS_XN = WS_W2 + (size_t)DFF * DM * 2;
constexpr size_t WS_Z = WS_XN + (size_t)NTOK * DM * 2;
constexpr size_t WS_MIX = WS_Z + (size_t)NTOK * LDZ * 2;
constexpr size_t WS_X1 = WS_MIX + (size_t)NTOK * DM * 2;
constexpr size_t WS_X2B = WS_X1 + (size_t)NTOK * DM * 4;
constexpr size_t WS_U = WS_X2B + (size_t)NTOK * DM * 4;
constexpr size_t WS_VEC = WS_U + (size_t)NTOK * DFF * 2;
constexpr size_t WS_STW = WS_VEC + (size_t)1536 * 256 * 4;
constexpr size_t WS_QK = WS_STW + (size_t)1536 * 8192 * 2;
constexpr size_t WS_ZS = WS_QK + (size_t)1536 * 8192 * 2;
constexpr size_t WS_END = WS_ZS + (size_t)4 * 256 * 768 * 2;

#ifndef DUP
#define DUP 0
#endif
constexpr int LDS_BYTES = 132 * 1024;

struct Args {
    const float* x_prompt; const float* x_sample; const float* c; const float* st_gla; const float* st_C; const float* st_n; const float* st_m; const float* c_ctx;
    const float* w_ada; const float* b_ada; const float* norm1_w; const float* norm2_w; const float* w_in; const float* w_alpha2; const float* b_alpha; const float* b_mgate;
    const float* conv_w; const float* gnorm_a_w; const float* gnorm_b_w; const float* w_out; const float* w_ff1; const float* w_ff2; const float* final_norm_w;
    float* out; unsigned char* ws;
};

__device__ __forceinline__ int fresh_tid() { int t = threadIdx.x; asm volatile("" : "+v"(t)); return t; }
__device__ __forceinline__ float bflo(unsigned w) { return __uint_as_float(w << 16); }
__device__ __forceinline__ float bfhi(unsigned w) { return __uint_as_float(w & 0xffff0000u); }
typedef __bf16 bf16x2v_ __attribute__((ext_vector_type(2)));
typedef float f32x2v_ __attribute__((ext_vector_type(2)));
__device__ __forceinline__ unsigned cvt_pk_bf16(float lo, float hi) { const f32x2v_ f = {lo, hi}; const bf16x2v_ b = __builtin_convertvector(f, bf16x2v_); return __builtin_bit_cast(unsigned, b); }
__device__ __forceinline__ bf16_t f2bf1(float x) { return (bf16_t)(cvt_pk_bf16(x, x) & 0xffffu); }
__device__ __forceinline__ float logsig(float x) { return fminf(x, 0.f) - __logf(1.f + __expf(-fabsf(x))); }
__device__ __forceinline__ float sigmoidf_(float x) { return 1.f / (1.f + __expf(-x)); }
__device__ __forceinline__ float siluf_(float x) { return x / (1.f + __expf(-x)); }
__device__ __forceinline__ float wave_sum(float v) {
#pragma unroll
    for (int o = 1; o < 64; o <<= 1) v += __shfl_xor(v, o);
    return v;
}
__device__ __forceinline__ float scan_sum(float v, int lane, int rev) {
#pragma unroll
    for (int o = 1; o < 64; o <<= 1) {
        const float t = rev ? __shfl_down(v, o) : __shfl_up(v, o);
        const bool ok = rev ? (lane + o < 64) : (lane >= o);
        v += ok ? t : 0.f;
    }
    return v;
}
__device__ __forceinline__ float scan_max(float v, int lane, int rev) {
#pragma unroll
    for (int o = 1; o < 64; o <<= 1) {
        const float t = rev ? __shfl_down(v, o) : __shfl_up(v, o);
        const bool ok = rev ? (lane + o < 64) : (lane >= o);
        v = ok ? fmaxf(v, t) : v;
    }
    return v;
}
__device__ __forceinline__ void unpack8(const u32x4 a, float (&f)[8]) {
    f[0] = bflo(a.x); f[1] = bfhi(a.x); f[2] = bflo(a.y); f[3] = bfhi(a.y); f[4] = bflo(a.z); f[5] = bfhi(a.z); f[6] = bflo(a.w); f[7] = bfhi(a.w);
}
__device__ __forceinline__ u32x4 pack8(const float (&f)[8]) {
    u32x4 o; o.x = cvt_pk_bf16(f[0], f[1]); o.y = cvt_pk_bf16(f[2], f[3]); o.z = cvt_pk_bf16(f[4], f[5]); o.w = cvt_pk_bf16(f[6], f[7]); return o;
}


#define XB_TMO      128
#define XB_XCNT(j)  (256  + 64 * (j))
#define XB_XSUB(j)  (1280 + 64 * (j))
#define XB_XGEN(j)  (2304 + 64 * (j))
#define XB_TOP      3328
#define XB_TOPGEN   3392
#define XB_LSUB(j)  (3456 + 64 * (j))
#define XB_LGEN(j)  (4480 + 64 * (j))
#define XCD_BAR_WORDS 5504
#define XB_SPIN_CAP (1u << 18)
__device__ __forceinline__ unsigned xb_ld(unsigned* p)              { return __hip_atomic_load(p, __ATOMIC_RELAXED, __HIP_MEMORY_SCOPE_AGENT); }
__device__ __forceinline__ unsigned xb_add(unsigned* p, unsigned v) { return __hip_atomic_fetch_add(p, v, __ATOMIC_RELAXED, __HIP_MEMORY_SCOPE_AGENT); }
__device__ __forceinline__ unsigned xb_xcc_id() { return (unsigned)__builtin_amdgcn_s_getreg((3 << 11) | 20) & 0xFu; }
#define XB_SPIN(cond, bar) do { unsigned _sp = 0; while (cond) { __builtin_amdgcn_s_sleep(1); \
    if ((++_sp & 255u) == 0u) { if (xb_ld(&(bar)[XB_TMO])) break; if (_sp > XB_SPIN_CAP) { atomicAdd(&(bar)[XB_TMO], 1u); break; } } } } while (0)
struct XcdBarrier { unsigned* bar; unsigned x; volatile LAS unsigned* st; };
__device__ __forceinline__ XcdBarrier xcd_barrier_post(unsigned* bar, volatile LAS unsigned* st) {
    XcdBarrier b; b.bar = bar; b.x = xb_xcc_id(); b.st = st;
    if (threadIdx.x == 0) { st[2] = xb_add(&bar[XB_XCNT(b.x)], 1u); st[3] = b.x; }
    return b;
}
__device__ __forceinline__ void xcd_barrier_complete(unsigned* bar, unsigned x, unsigned& nloc, unsigned& nx) {
    const unsigned G = gridDim.x * gridDim.y * gridDim.z;
    unsigned sum, cnt, mine, sp = 0u;
    for (;;) {
        sum = 0u; cnt = 0u; mine = 0u;
#pragma unroll
        for (unsigned j = 0; j < 16; ++j) { const unsigned c = xb_ld(&bar[XB_XCNT(j)]); sum += c; cnt += (c > 0u) ? 1u : 0u; mine = (j == x) ? c : mine; }
        if (sum == G) break;
        __builtin_amdgcn_s_sleep(1);
        if ((++sp & 255u) == 0u) { if (xb_ld(&bar[XB_TMO])) break; if (sp > XB_SPIN_CAP) { atomicAdd(&bar[XB_TMO], 1u); break; } }
    }
    nloc = mine > 0u ? mine : 1u; nx = cnt > 0u ? cnt : 1u;
}
__device__ __forceinline__ void xcd_barrier(const XcdBarrier& b) {
    asm volatile("s_waitcnt vmcnt(0)" ::: "memory");
    __syncthreads();
    if (threadIdx.x == 0) {
        unsigned* bar = b.bar;
        __builtin_amdgcn_s_waitcnt(0);
        unsigned nloc = b.st[0], nx = b.st[1];
        if (nloc == 0u) { xcd_barrier_complete(bar, b.x, nloc, nx); b.st[0] = nloc; b.st[1] = nx; }
        const unsigned old = xb_add(&bar[XB_XSUB(b.x)], 1u);
        const unsigned gen = old / nloc;
        if (old + 1u == (gen + 1u) * nloc) {
            __builtin_amdgcn_fence(__ATOMIC_RELEASE, "agent");
            asm volatile("s_waitcnt vmcnt(0)" ::: "memory");
            const unsigned og = xb_add(&bar[XB_TOP], 1u);
            const unsigned tg = og / nx;
            if (og + 1u == (tg + 1u) * nx) xb_add(&bar[XB_TOPGEN], 1u);
            else XB_SPIN(xb_ld(&bar[XB_TOPGEN]) == tg, bar);
            __builtin_amdgcn_fence(__ATOMIC_ACQUIRE, "agent");
            xb_add(&bar[XB_XGEN(b.x)], 1u);
            asm volatile("s_waitcnt vmcnt(0)" ::: "memory");
        } else {
            XB_SPIN(xb_ld(&bar[XB_XGEN(b.x)]) == gen, bar);
            __builtin_amdgcn_fence(__ATOMIC_ACQUIRE, "agent");
            asm volatile("s_waitcnt vmcnt(0)" ::: "memory");
        }
    }
    __syncthreads();
}

__device__ __forceinline__ void xcd_local_barrier(const XcdBarrier& b) {
    asm volatile("s_waitcnt vmcnt(0)" ::: "memory");
    __syncthreads();
    if (threadIdx.x == 0) {
        unsigned* bar = b.bar;
        __builtin_amdgcn_s_waitcnt(0);
        const unsigned nloc = b.st[0];
        const unsigned old = xb_add(&bar[XB_LSUB(b.x)], 1u);
        const unsigned gen = old / nloc;
        if (old + 1u == (gen + 1u) * nloc) xb_add(&bar[XB_LGEN(b.x)], 1u);
        else XB_SPIN(xb_ld(&bar[XB_LGEN(b.x)]) == gen, bar);
        __builtin_amdgcn_fence(__ATOMIC_ACQUIRE, "agent");
        asm volatile("s_waitcnt vmcnt(0)" ::: "memory");
    }
    __syncthreads();
}

namespace pg8 {
constexpr int BM = 256, BK = 64, HALF = 128, HTB = HALF * BK * 2, STAGE_BYTES = 8 * HTB, NXCD = 8, WGM = 8;
__host__ __device__ __forceinline__ int lds_byte(int r, int c) { const int st = (r >> 4) * 2 + (c >> 5), rr = r & 15, cc = c & 31, ob = rr * 64 + cc * 2; return st * 1024 + (ob ^ (((ob >> 9) & 1) << 5)); }
__host__ __device__ __forceinline__ void stage_rc(int b, int& R, int& C) { const int st = b / 1024, sb = b % 1024, swz = sb ^ (((sb >> 9) & 1) << 5); R = (st >> 1) * 16 + swz / 64; C = (st & 1) * 32 + (swz % 64) / 2; }
__host__ __device__ __forceinline__ int perm32(int rho) { const int n = rho >> 4, i = rho & 15; return 8 * (i >> 2) + 4 * n + (i & 3); }

struct Unit { int pm, pn, ks, sh; };
struct Gemm { const bf16_t* A; const bf16_t* Bt; int lda, ldb, K; };

struct Order {
    int nM, nN, nmn, ntot, G, c, aff, ks_, halo = 0;
    __device__ void init(int M, int N, int KS, int G_, int c_) { nM = M / BM; nN = N / BM; nmn = nM * nN; ntot = nmn * KS; G = G_; c = c_; ks_ = KS; aff = (G_ == 256 && nM == 24) ? 1 : 0; }
    __device__ bool next(int i, Unit& u) const {
        int pm, pn, ks, sh = 0;
        if (aff) {
            const int x = c & 7, li = c >> 3, per = nN * ks_, e = li + 32 * i;
            if (e < 3 * per) { const int r = e / 3, q = e - 3 * r;
                pm = 3 * x + q; pn = r / ks_; ks = r - pn * ks_; }
            else {
                if (!halo) return false;
                const int k = e - 3 * per, npan = (x == 6) ? 2 : ((x == 5 || x == 7) ? 1 : 0);
                if (k >= 3 * npan) return false;
                const int which = k / 3; pn = 6 + (k - 3 * which); ks = 0; sh = 1;
                pm = (x == 5) ? 18 : (x == 7) ? 20 : (which == 0 ? 17 : 21);
            }
        } else {
            const int L = i * G + c; if (L >= ntot) return false;
            ks = L / nmn; int wgid = L - ks * nmn;
            { const int q = nmn / NXCD, r = nmn % NXCD, xcd = wgid % NXCD, off = wgid / NXCD; wgid = (xcd < r ? xcd * (q + 1) : r * (q + 1) + (xcd - r) * q) + off; }
            const int nig = WGM * nN, gid = wgid / nig, fm = gid * WGM, gsz = (nM - fm) < WGM ? (nM - fm) : WGM;
            pm = fm + ((wgid % nig) % gsz); pn = (wgid % nig) / gsz;
        }
        u.pm = pm; u.pn = pn; u.ks = ks; u.sh = sh; return true;
    }
};

template <int ACT  > struct EpiBf16 {
    static constexpr bool PERM = true;
    bf16_t* O; int ldc; bf16_t* ZS = nullptr;
    __device__ __forceinline__ void operator()(const f32x4 (&acc)[2][2][4][2], const Unit& u, int wr, int wc, int fr, int fq) const {
        const int row0 = u.pm * BM + wr * 64 + fr, col0 = u.pn * BM + wc * 32 + 8 * fq;
#pragma unroll
        for (int ai = 0; ai < 2; ++ai)
#pragma unroll
            for (int m = 0; m < 4; ++m) { bf16_t* rowp = O + (size_t)(row0 + ai * HALF + m * 16) * ldc + col0;
                if (u.sh) { const int sp = (u.pm == 17) ? 0 : (u.pm == 18) ? 1 : (u.pm == 20) ? 2 : 3;
                    rowp = ZS + ((size_t)sp * 256 + (row0 - u.pm * BM) + ai * HALF + m * 16) * 768 + (col0 - 1536); }
#pragma unroll
                for (int bj = 0; bj < 2; ++bj) { f32x4 v0 = acc[ai][bj][m][0], v1 = acc[ai][bj][m][1];
                    if (ACT == 1) {
#pragma unroll
                        for (int j = 0; j < 4; ++j) { const float a = fmaxf(v0[j], 0.f), b = fmaxf(v1[j], 0.f); v0[j] = a * a; v1[j] = b * b; } }
                    u32x4 w; w.x = cvt_pk_bf16(v0[0], v0[1]); w.y = cvt_pk_bf16(v0[2], v0[3]); w.z = cvt_pk_bf16(v1[0], v1[1]); w.w = cvt_pk_bf16(v1[2], v1[3]);
                    *(u32x4*)(rowp + bj * HALF) = w; } }
    }
};
struct EpiRes {
    static constexpr bool PERM = false;
    const float* xp; const float* xs;
    float* o0; float* o1;
    const float* mod; const float* bada; int goff; int mode;
    __device__ __forceinline__ void operator()(const f32x4 (&acc)[2][2][4][2], const Unit& u, int wr, int wc, int fr, int fq) const {
        const int row0 = u.pm * BM + wr * 64 + fr, col0 = u.pn * BM + wc * 32 + 4 * fq;
        const int cond = u.pm < 16 ? 0 : 1 + ((u.pm - 16) >> 2);
        f32x4 gv[2][2];
#pragma unroll
        for (int bj = 0; bj < 2; ++bj)
#pragma unroll
            for (int n = 0; n < 2; ++n) gv[bj][n] = *(const f32x4*)(mod + cond * 6144 + goff + col0 + bj * HALF + n * 16) + *(const f32x4*)(bada + goff + col0 + bj * HALF + n * 16);
        float* outb = (u.ks == 0) ? o0 : o1;
#pragma unroll
        for (int ai = 0; ai < 2; ++ai)
#pragma unroll
            for (int m = 0; m < 4; ++m) { const int r = row0 + ai * HALF + m * 16;
                const float* bp = nullptr;
                if (mode == 0) bp = (r < NPR ? xp + (size_t)r * DM : xs + (size_t)(r - NPR) * DM) + col0;
                else if (u.ks == 0) bp = o0 + (size_t)r * DM + col0;
                float* op = outb + (size_t)r * DM + col0;
#pragma unroll
                for (int bj = 0; bj < 2; ++bj)
#pragma unroll
                    for (int n = 0; n < 2; ++n) { f32x4 v = gv[bj][n] * acc[ai][bj][m][n]; if (bp) v += *(const f32x4*)(bp + bj * HALF + n * 16); *(f32x4*)(op + bj * HALF + n * 16) = v; } }
    }
};

template <class Epi>
__device__ __forceinline__ void gemm_phase(LAS unsigned char* lds, const Gemm g, const Order& S, const Epi& E) {
    const int tid = fresh_tid(), wid = __builtin_amdgcn_readfirstlane(tid >> 6), lane = tid & 63, wr = wid >> 2, wc = wid & 3, fr = lane & 15, fq = lane >> 4;
    const int nt = g.K / BK;
    unsigned voffA[2], voffB[2];
#pragma unroll
    for (int i = 0; i < 2; ++i) { int R, C; stage_rc(tid * 16 + i * 8192, R, C); const int Rb = Epi::PERM ? ((R & ~31) + perm32(R & 31)) : R;
        voffA[i] = (unsigned)(R * g.lda + C) * 2u; voffB[i] = (unsigned)(Rb * g.ldb + C) * 2u; }
    const size_t kstep = (size_t)(BK * 2);
    const size_t hstepA = (size_t)HALF * g.lda * 2, hstepB = (size_t)HALF * g.ldb * 2;
    const size_t tstepA = 2 * hstepA, tstepB = 2 * hstepB;
    const unsigned ldsw = (unsigned)wid * 1024u;
    const int aoff = lds_byte(wr * 64 + fr, fq * 8), boff = lds_byte(wc * 32 + fr, fq * 8);
#define PG8_SA(b, h) (((b) * 2 + (h)) * HTB)
#define PG8_SB(b, h) ((4 + (b) * 2 + (h)) * HTB)
#define PG8_STAGE(bufoff, gbase, voff) do { _Pragma("unroll") for (int _i = 0; _i < 2; ++_i) \
        __builtin_amdgcn_global_load_lds((const unsigned*)((const char*)(gbase) + (voff)[_i]), (LAS unsigned*)(lds + (bufoff) + ldsw + _i * 8192), 16, 0, 0); } while (0)
#define PG8_LDA(dst, b, h) do { _Pragma("unroll") for (int m = 0; m < 4; ++m) _Pragma("unroll") for (int k = 0; k < 2; ++k) dst[m][k] = *(const LAS bf16x8*)(lds + PG8_SA(b, h) + aoff + m * 2048 + k * 1024); } while (0)
#define PG8_LDB(dst, b, h) do { _Pragma("unroll") for (int n = 0; n < 2; ++n) _Pragma("unroll") for (int k = 0; k < 2; ++k) dst[n][k] = *(const LAS bf16x8*)(lds + PG8_SB(b, h) + boff + n * 2048 + k * 1024); } while (0)
#define PG8_MMA(ai, bj, At, Bt) do { __builtin_amdgcn_s_setprio(1); _Pragma("unroll") for (int m = 0; m < 4; ++m) _Pragma("unroll") for (int n = 0; n < 2; ++n) _Pragma("unroll") for (int k = 0; k < 2; ++k) \
        acc[ai][bj][m][n] = __builtin_amdgcn_mfma_f32_16x16x32_bf16(Bt[n][k], At[m][k], acc[ai][bj][m][n], 0, 0, 0); __builtin_amdgcn_s_setprio(0); } while (0)
#define PG8_WAIT_V(n) asm volatile("s_waitcnt vmcnt(" #n ")" ::: "memory")
#define PG8_WAIT_L(n) asm volatile("s_waitcnt lgkmcnt(" #n ")" ::: "memory")
#define PG8_BAR __builtin_amdgcn_s_barrier()
#define PG8_SCHED __builtin_amdgcn_sched_barrier(0)
    Unit cur, nxt; int ui = 0;
    if (!S.next(0, cur)) return;
    f32x4 acc[2][2][4][2];
#pragma unroll
    for (int a = 0; a < 2; ++a)
#pragma unroll
        for (int b = 0; b < 2; ++b)
#pragma unroll
            for (int m = 0; m < 4; ++m)
#pragma unroll
                for (int n = 0; n < 2; ++n) acc[a][b][m][n] = (f32x4){0.f, 0.f, 0.f, 0.f};
    bf16x8 At[4][2], B0[2][2], B1[2][2];
    const size_t koffb = (size_t)g.K * 2;
    const char* cA = (const char*)g.A + (size_t)cur.pm * tstepA + (size_t)cur.ks * koffb; const char* cB = (const char*)g.Bt + (size_t)cur.pn * tstepB + (size_t)cur.ks * koffb;
    PG8_STAGE(PG8_SB(0, 0), cB, voffB); PG8_STAGE(PG8_SB(0, 1), cB + hstepB, voffB); PG8_STAGE(PG8_SA(0, 0), cA, voffA); PG8_STAGE(PG8_SA(0, 1), cA + hstepA, voffA);
    if (wr == 1) PG8_BAR;
    PG8_WAIT_V(2); PG8_BAR;
    PG8_STAGE(PG8_SB(1, 0), cB + kstep, voffB); PG8_STAGE(PG8_SA(1, 0), cA + kstep, voffA); PG8_STAGE(PG8_SB(1, 1), cB + hstepB + kstep, voffB);
    PG8_WAIT_V(6); PG8_BAR;
    for (;;) {
        const bool has_next = S.next(ui + 1, nxt);
        const char* nA = has_next ? (const char*)g.A + (size_t)nxt.pm * tstepA + (size_t)nxt.ks * koffb : cA; const char* nB = has_next ? (const char*)g.Bt + (size_t)nxt.pn * tstepB + (size_t)nxt.ks * koffb : cB;
        for (int t = 0; t < nt; t += 2) {
            const bool last = (t == nt - 2);
            const char* a1 = cA + (size_t)(t + 1) * kstep;
            const char* a2 = last ? nA : cA + (size_t)(t + 2) * kstep; const char* b2 = last ? nB : cB + (size_t)(t + 2) * kstep;
            const char* a3 = a2 + kstep; const char* b3 = b2 + kstep;
            PG8_LDB(B0, 0, 0); PG8_LDB(B1, 0, 1); PG8_SCHED; PG8_LDA(At, 0, 0); PG8_STAGE(PG8_SA(1, 1), a1 + hstepA, voffA);
            PG8_WAIT_V(8); PG8_WAIT_L(0); PG8_BAR; PG8_MMA(0, 0, At, B0); PG8_MMA(0, 1, At, B1); PG8_BAR; PG8_SCHED;
            PG8_LDA(At, 0, 1); PG8_STAGE(PG8_SB(0, 0), b2, voffB); PG8_STAGE(PG8_SB(0, 1), b2 + hstepB, voffB); PG8_STAGE(PG8_SA(0, 0), a2, voffA);
            PG8_WAIT_V(8); PG8_WAIT_L(0); PG8_BAR; PG8_MMA(1, 0, At, B0); PG8_MMA(1, 1, At, B1); PG8_BAR; PG8_SCHED;
            PG8_LDB(B0, 1, 0); PG8_LDB(B1, 1, 1); PG8_SCHED; PG8_LDA(At, 1, 0); PG8_STAGE(PG8_SA(0, 1), a2 + hstepA, voffA);
            PG8_WAIT_V(8); PG8_WAIT_L(0); PG8_BAR; PG8_MMA(0, 0, At, B0); PG8_MMA(0, 1, At, B1); PG8_BAR; PG8_SCHED;
            PG8_LDA(At, 1, 1); PG8_STAGE(PG8_SB(1, 0), b3, voffB); PG8_STAGE(PG8_SB(1, 1), b3 + hstepB, voffB); PG8_STAGE(PG8_SA(1, 0), a3, voffA);
            PG8_WAIT_V(8); PG8_WAIT_L(0); PG8_BAR; PG8_MMA(1, 0, At, B0); PG8_MMA(1, 1, At, B1); PG8_BAR; PG8_SCHED;
        }
        if (wr == 0) PG8_BAR;
        E(acc, cur, wr, wc, fr, fq);
        if (!has_next) break;
#pragma unroll
        for (int a = 0; a < 2; ++a)
#pragma unroll
            for (int b = 0; b < 2; ++b)
#pragma unroll
                for (int m = 0; m < 4; ++m)
#pragma unroll
                    for (int n = 0; n < 2; ++n) acc[a][b][m][n] = (f32x4){0.f, 0.f, 0.f, 0.f};
        cur = nxt; cA = nA; cB = nB; ++ui;
        if (wr == 1) PG8_BAR;
    }
    PG8_WAIT_V(0);
    PG8_BAR;
#undef PG8_SA
#undef PG8_SB
#undef PG8_STAGE
#undef PG8_LDA
#undef PG8_LDB
#undef PG8_MMA
#undef PG8_WAIT_V
#undef PG8_WAIT_L
#undef PG8_BAR
#undef PG8_SCHED
}
}

__device__ __forceinline__ void transpose_item(const float* W, int K, int N, int NP, bf16_t* WT, LAS float* scr, int item, int lane) {
    const int nblk = NP / 32, kb = item / nblk, nb = item % nblk, k0 = 64 * kb, n0 = 32 * nb;
    const int nn = n0 + (lane & 31); const bool ok = nn < N;
    float tv[32];
    const float* wp = W + (size_t)(k0 + (lane >> 5)) * N + nn;
#pragma unroll
    for (int i = 0; i < 32; ++i) tv[i] = ok ? __builtin_nontemporal_load(wp + (size_t)(2 * i) * N) : 0.f;
#pragma unroll
    for (int i = 0; i < 32; ++i) scr[(2 * i + (lane >> 5)) * 33 + (lane & 31)] = tv[i];
    asm volatile("s_waitcnt lgkmcnt(0)" ::: "memory");
    const int c = lane & 7;
#pragma unroll
    for (int j = 0; j < 4; ++j) { const int n = (lane >> 3) + 8 * j; const LAS float* s = scr + (8 * c) * 33 + n;
        u32x4 o; o.x = cvt_pk_bf16(s[0 * 33], s[1 * 33]); o.y = cvt_pk_bf16(s[2 * 33], s[3 * 33]); o.z = cvt_pk_bf16(s[4 * 33], s[5 * 33]); o.w = cvt_pk_bf16(s[6 * 33], s[7 * 33]);
        *(u32x4*)(WT + (size_t)(n0 + n) * K + k0 + 8 * c) = o; }
    asm volatile("s_waitcnt lgkmcnt(0)" ::: "memory");
}

__device__ __forceinline__ void norm_mod_row(const float* xrow, const float* nw, const float* mod, const float* bada, int sh_off, int sc_off, bf16_t* orow, int lane) {
    const f32x4* xr = (const f32x4*)xrow + lane;
    f32x4 v[4]; float s = 0.f;
#pragma unroll
    for (int j = 0; j < 4; ++j) { v[j] = xr[64 * j]; s += (v[j].x * v[j].x + v[j].y * v[j].y) + (v[j].z * v[j].z + v[j].w * v[j].w); }
    const float rstd = rsqrtf(wave_sum(s) * (1.f / DM) + EPS);
#pragma unroll
    for (int j = 0; j < 4; ++j) { const int col = 4 * lane + 256 * j;
        const f32x4 w = *(const f32x4*)(nw + col);
        const f32x4 sc = *(const f32x4*)(mod + sc_off + col) + *(const f32x4*)(bada + sc_off + col);
        const f32x4 sh = *(const f32x4*)(mod + sh_off + col) + *(const f32x4*)(bada + sh_off + col);
        const f32x4 y = v[j] * rstd * w * (sc + 1.f) + sh;
        u32x2 o; o.x = cvt_pk_bf16(y.x, y.y); o.y = cvt_pk_bf16(y.z, y.w);
        *(u32x2*)(orow + col) = o; }
}

constexpr int LROW = 72;
constexpr int L_QS = 0, L_KS = 9216, L_KT = 18432, L_P = 27648, L_VT = 36864, L_ST = 57600, L_VEC = 78336, L_RED = 79360;
constexpr int L_WA = 79872;


__device__ __forceinline__ bf16x8 frag(const LAS bf16_t* base, int row, int kofs) { return *(const LAS bf16x8*)(base + row * LROW + kofs); }
__device__ __forceinline__ f32x4 mma(bf16x8 a, bf16x8 b, f32x4 c) { return __builtin_amdgcn_mfma_f32_16x16x32_bf16(a, b, c, 0, 0, 0); }

__device__ __forceinline__ void stage_vT(const bf16_t* zr, int vcol0, LAS bf16_t* VT, int w, int l) {
    const u32x4* vp = (const u32x4*)(zr + vcol0 + 16 * w);
    const u32x4 a = vp[0], b = vp[1];
    LAS bf16_t* vt = VT + (16 * w) * LROW + l;
    vt[0 * LROW] = (bf16_t)(a.x & 0xffffu); vt[1 * LROW] = (bf16_t)(a.x >> 16); vt[2 * LROW] = (bf16_t)(a.y & 0xffffu); vt[3 * LROW] = (bf16_t)(a.y >> 16);
    vt[4 * LROW] = (bf16_t)(a.z & 0xffffu); vt[5 * LROW] = (bf16_t)(a.z >> 16); vt[6 * LROW] = (bf16_t)(a.w & 0xffffu); vt[7 * LROW] = (bf16_t)(a.w >> 16);
    vt[8 * LROW] = (bf16_t)(b.x & 0xffffu); vt[9 * LROW] = (bf16_t)(b.x >> 16); vt[10 * LROW] = (bf16_t)(b.y & 0xffffu); vt[11 * LROW] = (bf16_t)(b.y >> 16);
    vt[12 * LROW] = (bf16_t)(b.z & 0xffffu); vt[13 * LROW] = (bf16_t)(b.z >> 16); vt[14 * LROW] = (bf16_t)(b.w & 0xffffu); vt[15 * LROW] = (bf16_t)(b.w >> 16);
}

__device__ __forceinline__ void stage_weights(const Args& P, LAS unsigned char* lds, int type, int h, int tid) {
    LAS float* WA = (LAS float*)(lds + L_WA);
    if (type == 0) {
        for (int i = tid; i < 2 * 17 * 64; i += NTHR) { const int dir = i / (17 * 64), r = (i / 64) % 17, d = i & 63;
            WA[i] = (r < 16) ? P.w_alpha2[(dir * 16 + r) * 256 + h * 64 + d] : P.b_alpha[dir * 256 + h * 64 + d]; }
    } else {
        for (int i = tid; i < 9 * 128; i += NTHR) { const int tap = i >> 7, c = i & 127;
            WA[i] = P.conv_w[tap * 512 + (c < 64 ? h * 64 + c : 256 + h * 64 + (c - 64))]; }
    }
}
__device__ __forceinline__ void gla_gate(LAS unsigned char* lds, const bf16_t* zr, int dir, int w, int l, float (&b)[8], float (&bL)[8]) {
    const LAS float* WA = (const LAS float*)(lds + L_WA) + dir * 17 * 64 + 8 * w;
    const u32x4* rp = (const u32x4*)(zr + RA + dir * 16);
    float ra[16];
    { float t0[8], t1[8]; unpack8(rp[0], t0); unpack8(rp[1], t1);
#pragma unroll
      for (int i = 0; i < 8; ++i) { ra[i] = t0[i]; ra[8 + i] = t1[i]; } }
    float x[8];
    { const f32x4 c0 = *(const LAS f32x4*)(WA + 16 * 64), c1 = *(const LAS f32x4*)(WA + 16 * 64 + 4);
      x[0] = c0.x; x[1] = c0.y; x[2] = c0.z; x[3] = c0.w; x[4] = c1.x; x[5] = c1.y; x[6] = c1.z; x[7] = c1.w; }
#pragma unroll
    for (int r = 0; r < 16; ++r) { if ((r & 3) == 0) __builtin_amdgcn_sched_barrier(0);
        const f32x4 w0 = *(const LAS f32x4*)(WA + r * 64), w1 = *(const LAS f32x4*)(WA + r * 64 + 4);
        x[0] += ra[r] * w0.x; x[1] += ra[r] * w0.y; x[2] += ra[r] * w0.z; x[3] += ra[r] * w0.w; x[4] += ra[r] * w1.x; x[5] += ra[r] * w1.y; x[6] += ra[r] * w1.z; x[7] += ra[r] * w1.w; }
#pragma unroll
    for (int dd = 0; dd < 8; ++dd) {
        const float g = logsig(x[dd]) * (1.f / 16.f);
        b[dd] = scan_sum(g, l, dir);
        bL[dd] = __shfl(b[dd], dir ? 0 : 63);
    }
}

__device__ __forceinline__ void ml_gate(const Args& P, const bf16_t* zr, int dir, int h, int l, float& F, float& u, float& mloc) {
    const float ig = bflo((unsigned)zr[GB + (2 * dir) * 4 + h]) + P.b_mgate[(2 * dir) * 4 + h];
    const float fg = bflo((unsigned)zr[GB + (2 * dir + 1) * 4 + h]) + P.b_mgate[(2 * dir + 1) * 4 + h];
    const float lf = logsig(fg);
    F = scan_sum(lf, l, dir);
    u = ig - F;
    mloc = F + scan_max(u, l, dir);
}

template <bool WANT_Q>
__device__ __forceinline__ void ml_conv(LAS unsigned char* lds, const bf16_t* Z, const bf16_t* ZS, int hx, int cgi, int n, bool sample, int h, int w, int l, float (&qv)[8], float (&kv)[8]) {
    const LAS float* WA = (const LAS float*)(lds + L_WA);
    float aq[8], ak[8];
#pragma unroll
    for (int i = 0; i < 8; ++i) { aq[i] = 0.f; ak[i] = 0.f; }
    const int chq = h * 64 + 8 * w;
#pragma unroll
    for (int dr = -1; dr <= 1; ++dr) {
        if (!sample && dr != 0) continue;
        const bool rok = sample ? (n + dr >= 0 && n + dr < 16) : true;
#pragma unroll
        for (int dc = -1; dc <= 1; ++dc) {
            const int col = l + dc;
            const bool cok = sample ? (col >= 0 && col < 64) : (64 * n + col >= 0 && 64 * n + col < 256);
            const bool ok = rok && cok;
            const long rr = (long)64 * (cgi + dr) + col;
            u32x4 zq = (u32x4){0u, 0u, 0u, 0u}, zk = (u32x4){0u, 0u, 0u, 0u};
            if (ok) { const bf16_t* zp = Z + (size_t)rr * LDZ + QB;
                if (dr != 0 && hx >= 0 && (cgi + dr) / 12 != hx) {
                    const int pr = (cgi + dr) >> 2, sp = (pr == 17) ? 0 : (pr == 18) ? 1 : (pr == 20) ? 2 : 3;
                    zp = ZS + ((size_t)sp * 256 + (rr & 255)) * 768 + (QB - 1536); }
                if (WANT_Q) zq = *(const u32x4*)(zp + chq); zk = *(const u32x4*)(zp + (KB - QB) + chq); }
            __builtin_amdgcn_sched_barrier(0);
            const LAS float* tp = WA + ((dr + 1) * 3 + (dc + 1)) * 128 + 8 * w;
            float fq[8], fk[8]; unpack8(zq, fq); unpack8(zk, fk);
            const f32x4 k0 = *(const LAS f32x4*)(tp + 64), k1 = *(const LAS f32x4*)(tp + 68);
            ak[0] += fk[0] * k0.x; ak[1] += fk[1] * k0.y; ak[2] += fk[2] * k0.z; ak[3] += fk[3] * k0.w; ak[4] += fk[4] * k1.x; ak[5] += fk[5] * k1.y; ak[6] += fk[6] * k1.z; ak[7] += fk[7] * k1.w;
            if (WANT_Q) { const f32x4 q0 = *(const LAS f32x4*)(tp), q1 = *(const LAS f32x4*)(tp + 4);
                aq[0] += fq[0] * q0.x; aq[1] += fq[1] * q0.y; aq[2] += fq[2] * q0.z; aq[3] += fq[3] * q0.w; aq[4] += fq[4] * q1.x; aq[5] += fq[5] * q1.y; aq[6] += fq[6] * q1.z; aq[7] += fq[7] * q1.w; }
        }
    }
#pragma unroll
    for (int i = 0; i < 8; ++i) { qv[i] = WANT_Q ? siluf_(aq[i]) * 0.125f : 0.f; kv[i] = siluf_(ak[i]); }
}

template <int type>
__device__ __forceinline__ void scan1_item(const Args& P, LAS unsigned char* lds, int cgi, int h, int hx) {
    const int tid = fresh_tid(), w = __builtin_amdgcn_readfirstlane(tid >> 6), l = tid & 63;
    const bf16_t* Z = (const bf16_t*)(P.ws + WS_Z);
    bf16_t* DS = (bf16_t*)(P.ws + WS_U); float* VEC = (float*)(P.ws + WS_VEC);
    LAS bf16_t* KT = (LAS bf16_t*)(lds + L_KT); LAS bf16_t* VT = (LAS bf16_t*)(lds + L_VT);
    const bf16_t* zr = Z + (size_t)(64 * cgi + l) * LDZ;
    const bool sample = cgi >= 64; const int n = sample ? (cgi & 15) : (cgi & 3);
    const int dt = w & 3, vh = w >> 2, lr = l & 15, lq = l >> 4;
    __syncthreads();
    float kf[8], qf[8];
    bf16_t* QK = (bf16_t*)(P.ws + WS_QK);
    if (type == 0) {
        stage_vT(zr, VA + h * 128, VT, w, l);
        unpack8(*(const u32x4*)(zr + KA + h * 64 + 8 * w), kf);
        unpack8(*(const u32x4*)(zr + QA + h * 64 + 8 * w), qf);
    } else {
        stage_vT(zr, VB + h * 128, VT, w, l);
        for (int i = tid; i < 16 * 64; i += NTHR) VT[(128 + (i >> 6)) * LROW + (i & 63)] = (i < 64) ? (bf16_t)0x3F80u : (bf16_t)0u;
        ml_conv<true>(lds, Z, (const bf16_t*)(P.ws + WS_ZS), hx, cgi, n, sample, h, w, l, qf, kf);
        bf16_t* qk0 = QK + (size_t)(((96 + cgi) * 4 + h) * 2) * 8192;
        *(u32x4*)(qk0 + l * 64 + 8 * w) = pack8(qf);
        *(u32x4*)(qk0 + 4096 + l * 64 + 8 * w) = pack8(kf);
    }
    for (int dir = 0; dir < 2; ++dir) {
        const int slot = ((type * 96 + cgi) * 4 + h) * 2 + dir;
        if (type == 0) {
            float b[8], bL[8]; gla_gate(lds, zr, dir, w, l, b, bL);
#pragma unroll
            for (int dd = 0; dd < 8; ++dd) KT[(8 * w + dd) * LROW + l] = f2bf1(kf[dd] * __expf(bL[dd] - b[dd]));
            if (l == 0) {
#pragma unroll
                for (int dd = 0; dd < 8; ++dd) VEC[slot * 256 + 8 * w + dd] = __expf(bL[dd]);
            }
            float qt[8], kt[8];
#pragma unroll
            for (int dd = 0; dd < 8; ++dd) { qt[dd] = qf[dd] * __expf(b[dd]) * 0.125f; kt[dd] = kf[dd] * __expf(-b[dd]); }
            *(u32x4*)(QK + (size_t)slot * 8192 + l * 64 + 8 * w) = pack8(qt);
            *(u32x4*)(QK + (size_t)slot * 8192 + 4096 + l * 64 + 8 * w) = pack8(kt);
        } else {
            float F, u, mloc; ml_gate(P, zr, dir, h, l, F, u, mloc);
            const float FL = __shfl(F, dir ? 0 : 63), mlL = __shfl(mloc, dir ? 0 : 63);
            const float wk = __expf(FL + u - mlL);
#pragma unroll
            for (int dd = 0; dd < 8; ++dd) KT[(8 * w + dd) * LROW + l] = f2bf1(kf[dd] * wk);
            if (w == 0 && l == 0) { VEC[slot * 256 + 64] = FL; VEC[slot * 256 + 65] = mlL; }
            if (w == 0) { float* gv = (float*)(QK + (size_t)(((96 + cgi) * 4 + h) * 2 + 1) * 8192) + dir * 192; gv[l] = F; gv[64 + l] = u; gv[128 + l] = mloc; }
        }
        __syncthreads();
        const bf16x8 kb0 = frag(KT, 16 * dt + lr, lq * 8), kb1 = frag(KT, 16 * dt + lr, lq * 8 + 32);
        bf16_t* dsp = DS + (size_t)slot * 8192 + (16 * dt + lr) * 128 + lq * 4;
#pragma unroll
        for (int i = 0; i < 4; ++i) { const int vt = 4 * vh + i;
            f32x4 acc = (f32x4){0.f, 0.f, 0.f, 0.f};
            acc = mma(frag(VT, 16 * vt + lr, lq * 8), kb0, acc); acc = mma(frag(VT, 16 * vt + lr, lq * 8 + 32), kb1, acc);
            u32x2 o2; o2.x = cvt_pk_bf16(acc[0], acc[1]); o2.y = cvt_pk_bf16(acc[2], acc[3]); *(u32x2*)(dsp + 16 * vt) = o2; }
        if (type == 1 && vh == 1) {
            f32x4 acc = (f32x4){0.f, 0.f, 0.f, 0.f};
            acc = mma(frag(VT, 128 + lr, lq * 8), kb0, acc); acc = mma(frag(VT, 128 + lr, lq * 8 + 32), kb1, acc);
            if (lq == 0) VEC[slot * 256 + 16 * dt + lr] = acc[0];
        }
        __syncthreads();
    }
}


__device__ __forceinline__ void prefix_unit(const Args& P, int unit) {
    const int tid = fresh_tid();
    int type, seq, h, dir, half;
    if (unit < 64) { half = unit & 1; const int c = unit >> 1; dir = c & 1; h = (c >> 1) & 3; seq = 16 + ((c >> 3) & 1); type = c >> 4; }
    else { const int u2 = unit - 64; half = u2 & 1; const int c = u2 >> 1; dir = c & 1; h = (c >> 1) & 3; seq = (c >> 3) & 15; type = c >> 7; }
    const bool sample = seq >= 16; const int NCH = sample ? 16 : 4; const int cgi0 = sample ? 64 + (seq - 16) * 16 : seq * 4; const int bs = sample ? seq - 16 : seq;
    const int v = tid & 127, dg = (tid >> 7) + 4 * half;
    const size_t sbase = (size_t)((bs * 2 + dir) * 4 + h);
    const bf16_t* DS = (const bf16_t*)(P.ws + WS_U); float* VEC = (float*)(P.ws + WS_VEC); bf16_t* STW = (bf16_t*)(P.ws + WS_STW);
    const bool nthr = (half == 0) && (tid < 64);
    float S[8]; float nst = 0.f, m_prev = 0.f;
    if (sample) {
        const float* s0 = (type == 0 ? P.st_gla : P.st_C) + sbase * 8192;
#pragma unroll
        for (int dd = 0; dd < 8; ++dd) S[dd] = s0[(8 * dg + dd) * 128 + v];
        if (type == 1) { nst = nthr ? P.st_n[sbase * 64 + tid] : 0.f; m_prev = P.st_m[sbase]; }
    } else {
#pragma unroll
        for (int dd = 0; dd < 8; ++dd) S[dd] = 0.f;
    }
    const int slot0 = ((type * 96 + cgi0) * 4 + h) * 2 + dir;
    for (int jb = 0; jb < NCH; jb += 4) {
        float D[4][8], DEC[4][8], SC[4][3];
#pragma unroll
        for (int uu = 0; uu < 4; ++uu) {
            const int j = dir ? NCH - 1 - (jb + uu) : jb + uu; const int slot = slot0 + 8 * j;
            const bf16_t* dsj = DS + (size_t)slot * 8192; const float* vj = VEC + slot * 256;
#pragma unroll
            for (int dd = 0; dd < 8; ++dd) D[uu][dd] = bflo((unsigned)dsj[(8 * dg + dd) * 128 + v]);
            if (type == 0) { const f32x4 e0 = *(const f32x4*)(vj + 8 * dg), e1 = *(const f32x4*)(vj + 8 * dg + 4);
                DEC[uu][0] = e0.x; DEC[uu][1] = e0.y; DEC[uu][2] = e0.z; DEC[uu][3] = e0.w; DEC[uu][4] = e1.x; DEC[uu][5] = e1.y; DEC[uu][6] = e1.z; DEC[uu][7] = e1.w; }
            else { SC[uu][0] = vj[64]; SC[uu][1] = vj[65]; SC[uu][2] = nthr ? vj[tid] : 0.f; }
        }
#pragma unroll
        for (int uu = 0; uu < 4; ++uu) {
            const int j = dir ? NCH - 1 - (jb + uu) : jb + uu; const int slot = slot0 + 8 * j;
            *(u32x4*)(STW + (size_t)slot * 8192 + v * 64 + 8 * dg) = pack8(S);
            float a = 1.f, bsc = 1.f;
            if (type == 1) {
                if (nthr) VEC[slot * 256 + 128 + tid] = nst;
                if (half == 0 && tid == 0) VEC[slot * 256 + 66] = m_prev;
                const float FLj = SC[uu][0], mlj = SC[uu][1]; const float m_new = fmaxf(FLj + m_prev, mlj);
                a = __expf(FLj + m_prev - m_new); bsc = __expf(mlj - m_new); m_prev = m_new;
                nst = a * nst + bsc * SC[uu][2];
            }
#pragma unroll
            for (int dd = 0; dd < 8; ++dd) S[dd] = ((type == 0) ? DEC[uu][dd] : a) * S[dd] + bsc * D[uu][dd];
        }
    }
    if (!sample) {
        float* og = P.out + (size_t)NTOK * DM + (type == 0 ? 0 : 1048576) + sbase * 8192;
#pragma unroll
        for (int dd = 0; dd < 8; ++dd) og[(8 * dg + dd) * 128 + v] = S[dd];
        if (type == 1) {
            if (nthr) P.out[(size_t)NTOK * DM + 2097152 + sbase * 64 + tid] = nst;
            if (half == 0 && tid == 0) P.out[(size_t)NTOK * DM + 2097152 + 8192 + sbase] = m_prev;
        }
    }
}

template <int type> struct S2A { u32x4 va, vb, q, k; };
template <int type> struct S2D { u32x4 q, k; float F, u, mloc, m_prev; const float* np; bf16x8 sf[4][2]; };

template <int type>
__device__ __forceinline__ void s2_loadA(const Args& P, int cgi, int h, int w, int l, int tt, int vh, int lr, int lq, S2A<type>& a) {
    const bf16_t* Z = (const bf16_t*)(P.ws + WS_Z);
    const bf16_t* zr = Z + (size_t)(64 * cgi + l) * LDZ;
    const u32x4* vp = (const u32x4*)(zr + (type == 0 ? VA : VB) + h * 128 + 16 * w);
    a.va = vp[0]; a.vb = vp[1];
    if (type == 1) { const bf16_t* qk0 = (const bf16_t*)(P.ws + WS_QK) + (size_t)(((96 + cgi) * 4 + h) * 2) * 8192;
        a.q = *(const u32x4*)(qk0 + l * 64 + 8 * w); a.k = *(const u32x4*)(qk0 + 4096 + l * 64 + 8 * w); }
}
template <int type>
__device__ __forceinline__ void s2_loadD(const Args& P, int cgi, int h, int dir, int w, int l, int vh, int lr, int lq, S2D<type>& d) {
    const int slot = ((type * 96 + cgi) * 4 + h) * 2 + dir;
    const bf16_t* stg = (const bf16_t*)(P.ws + WS_STW) + (size_t)slot * 8192;
#pragma unroll
    for (int i = 0; i < 4; ++i) { d.sf[i][0] = *(const bf16x8*)(stg + (16 * (4 * vh + i) + lr) * 64 + lq * 8); d.sf[i][1] = *(const bf16x8*)(stg + (16 * (4 * vh + i) + lr) * 64 + lq * 8 + 32); }
    const bf16_t* QK = (const bf16_t*)(P.ws + WS_QK);
    if (type == 0) { d.q = *(const u32x4*)(QK + (size_t)slot * 8192 + l * 64 + 8 * w); d.k = *(const u32x4*)(QK + (size_t)slot * 8192 + 4096 + l * 64 + 8 * w); }
    else {
        const float* VEC = (const float*)(P.ws + WS_VEC);
        const float* gv = (const float*)(QK + (size_t)(((96 + cgi) * 4 + h) * 2 + 1) * 8192) + dir * 192;
        d.F = gv[l]; d.u = gv[64 + l]; d.mloc = gv[128 + l]; d.m_prev = VEC[slot * 256 + 66];
        d.np = VEC + slot * 256 + 128 + lq * 8;
    }
}
template <int type>
__device__ __forceinline__ void s2_dir(LAS unsigned char* lds, const S2D<type>& d, int dir, int w, int l, int tt, int vh, int lr, int lq, const f32x4 (&qk)[2], f32x4 (&hs)[4]) {
    LAS bf16_t* QS = (LAS bf16_t*)(lds + L_QS); LAS bf16_t* KS = (LAS bf16_t*)(lds + L_KS); LAS bf16_t* PP = (LAS bf16_t*)(lds + L_P); LAS bf16_t* VT = (LAS bf16_t*)(lds + L_VT);
    LAS float* vecA = (LAS float*)(lds + L_VEC); LAS float* vecU = vecA + 64; LAS float* vecWI = vecA + 128; LAS float* vecMT = vecA + 192;
    const int st_ = w >> 1;
    f32x4 nn[4] = {(f32x4){0.f, 0.f, 0.f, 0.f}, (f32x4){0.f, 0.f, 0.f, 0.f}, (f32x4){0.f, 0.f, 0.f, 0.f}, (f32x4){0.f, 0.f, 0.f, 0.f}};
    if (type == 1) { nn[0] = *(const f32x4*)(d.np); nn[1] = *(const f32x4*)(d.np + 4); nn[2] = *(const f32x4*)(d.np + 32); nn[3] = *(const f32x4*)(d.np + 36); }
    if (type == 0) {
        *(LAS u32x4*)(QS + l * LROW + 8 * w) = d.q;
        *(LAS u32x4*)(KS + l * LROW + 8 * w) = d.k;
    } else {
        const float mt = fmaxf(d.F + d.m_prev, d.mloc);
        if (w == 0) { vecA[l] = d.F - mt; vecU[l] = d.u; vecWI[l] = __expf(d.F + d.m_prev - mt); vecMT[l] = mt; }
    }
    __syncthreads();
#pragma unroll
    for (int i = 0; i < 2; ++i) { const int tt2 = (w & 1) * 2 + i; const int s0 = 16 * st_ + 4 * lq, t = 16 * tt2 + lr;
        f32x4 a;
        if (type == 0) {
            a = (f32x4){0.f, 0.f, 0.f, 0.f};
            a = mma(frag(KS, 16 * st_ + lr, lq * 8), frag(QS, 16 * tt2 + lr, lq * 8), a);
            a = mma(frag(KS, 16 * st_ + lr, lq * 8 + 32), frag(QS, 16 * tt2 + lr, lq * 8 + 32), a);
        } else {
            const float At = vecA[t]; const f32x4 u4 = *(const LAS f32x4*)(vecU + s0);
#pragma unroll
            for (int j = 0; j < 4; ++j) a[j] = qk[i][j] * __expf(At + u4[j]);
        }
        float p[4];
#pragma unroll
        for (int j = 0; j < 4; ++j) { const bool keep = dir ? (s0 + j >= t) : (s0 + j <= t); p[j] = keep ? a[j] : 0.f; }
        u32x2 o; o.x = cvt_pk_bf16(p[0], p[1]); o.y = cvt_pk_bf16(p[2], p[3]);
        *(LAS u32x2*)(PP + t * LROW + s0) = o; }
    __syncthreads();
    const bf16x8 pb0 = frag(PP, 16 * tt + lr, lq * 8), pb1 = frag(PP, 16 * tt + lr, lq * 8 + 32);
    const bf16x8 qb0 = frag(QS, 16 * tt + lr, lq * 8), qb1 = frag(QS, 16 * tt + lr, lq * 8 + 32);
    if (type == 0) {
#pragma unroll
        for (int i = 0; i < 4; ++i) { const int vt = 4 * vh + i;
            f32x4 a = hs[i];
            a = mma(frag(VT, 16 * vt + lr, lq * 8), pb0, a); a = mma(frag(VT, 16 * vt + lr, lq * 8 + 32), pb1, a);
            a = mma(d.sf[i][0], qb0, a); a = mma(d.sf[i][1], qb1, a);
            hs[i] = a; }
    } else {
        const int t = 16 * tt + lr; const float wi_t = vecWI[t], mt_t = vecMT[t];
        f32x4 aI = (f32x4){0.f, 0.f, 0.f, 0.f}, aS = (f32x4){0.f, 0.f, 0.f, 0.f};
        {
            const short one = (lr == 0) ? (short)0x3F80 : (short)0;
            const bf16x8 onesf = (bf16x8){one, one, one, one, one, one, one, one};
            aI = mma(onesf, pb0, aI); aI = mma(onesf, pb1, aI);
            const float z = (lr == 0) ? 1.f : 0.f;
            float n0[8] = {nn[0].x * z, nn[0].y * z, nn[0].z * z, nn[0].w * z, nn[1].x * z, nn[1].y * z, nn[1].z * z, nn[1].w * z};
            float n1[8] = {nn[2].x * z, nn[2].y * z, nn[2].z * z, nn[2].w * z, nn[3].x * z, nn[3].y * z, nn[3].z * z, nn[3].w * z};
            const u32x4 p0 = pack8(n0), p1 = pack8(n1);
            aS = mma(__builtin_bit_cast(bf16x8, p0), qb0, aS); aS = mma(__builtin_bit_cast(bf16x8, p1), qb1, aS);
        }
        float den = aI[0] + wi_t * aS[0];
        den = __shfl(den, lr);
        const float inv = 1.f / fmaxf(fabsf(den), __expf(-mt_t));
#pragma unroll
        for (int i = 0; i < 4; ++i) { const int vt = 4 * vh + i;
            f32x4 bI = (f32x4){0.f, 0.f, 0.f, 0.f}, bS = (f32x4){0.f, 0.f, 0.f, 0.f};
            bI = mma(frag(VT, 16 * vt + lr, lq * 8), pb0, bI); bI = mma(frag(VT, 16 * vt + lr, lq * 8 + 32), pb1, bI);
            bS = mma(d.sf[i][0], qb0, bS); bS = mma(d.sf[i][1], qb1, bS);
            hs[i] += (bI + wi_t * bS) * inv; }
    }
    __syncthreads();
}

template <int type>
__device__ __forceinline__ void scan2_loop(const Args& P, LAS unsigned char* lds, int h, int cq, int cstep, int cend) {
    const int tid = fresh_tid(), w = __builtin_amdgcn_readfirstlane(tid >> 6), l = tid & 63;
    bf16_t* MIX = (bf16_t*)(P.ws + WS_MIX);
    LAS bf16_t* QS = (LAS bf16_t*)(lds + L_QS); LAS bf16_t* KS = (LAS bf16_t*)(lds + L_KS); LAS bf16_t* VT = (LAS bf16_t*)(lds + L_VT);
    LAS float* RED = (LAS float*)(lds + L_RED);
    const int tt = w & 3, vh = w >> 2, lr = l & 15, lq = l >> 4, st_ = w >> 1;
    f32x4 w4v[4];
#pragma unroll
    for (int i = 0; i < 4; ++i) w4v[i] = *(const f32x4*)((type == 0 ? P.gnorm_a_w : P.gnorm_b_w) + h * 128 + 16 * (4 * vh + i) + 4 * lq);
    S2A<type> A; S2D<type> D0;
    s2_loadA<type>(P, cq, h, w, l, tt, vh, lr, lq, A);
    s2_loadD<type>(P, cq, h, 0, w, l, vh, lr, lq, D0);
    for (int cgi = cq; cgi < cend; cgi += cstep) {
        const bool has_next = (cgi + cstep) < cend;
        S2D<type> D1; s2_loadD<type>(P, cgi, h, 1, w, l, vh, lr, lq, D1);
        u32x2 gzv[4];
        { const bf16_t* Z = (const bf16_t*)(P.ws + WS_Z); const size_t rowz = (size_t)64 * cgi + 16 * tt + lr;
#pragma unroll
          for (int i = 0; i < 4; ++i) gzv[i] = *(const u32x2*)(Z + rowz * LDZ + (type == 0 ? GA : OB) + h * 128 + 16 * (4 * vh + i) + 4 * lq); }
        S2A<type> An;
        if (has_next) s2_loadA<type>(P, cgi + cstep, h, w, l, tt, vh, lr, lq, An);
        __syncthreads();
        {
            LAS bf16_t* vt = VT + (16 * w) * LROW + l;
            const u32x4 a = A.va, b = A.vb;
            vt[0 * LROW] = (bf16_t)(a.x & 0xffffu); vt[1 * LROW] = (bf16_t)(a.x >> 16); vt[2 * LROW] = (bf16_t)(a.y & 0xffffu); vt[3 * LROW] = (bf16_t)(a.y >> 16);
            vt[4 * LROW] = (bf16_t)(a.z & 0xffffu); vt[5 * LROW] = (bf16_t)(a.z >> 16); vt[6 * LROW] = (bf16_t)(a.w & 0xffffu); vt[7 * LROW] = (bf16_t)(a.w >> 16);
            vt[8 * LROW] = (bf16_t)(b.x & 0xffffu); vt[9 * LROW] = (bf16_t)(b.x >> 16); vt[10 * LROW] = (bf16_t)(b.y & 0xffffu); vt[11 * LROW] = (bf16_t)(b.y >> 16);
            vt[12 * LROW] = (bf16_t)(b.z & 0xffffu); vt[13 * LROW] = (bf16_t)(b.z >> 16); vt[14 * LROW] = (bf16_t)(b.w & 0xffffu); vt[15 * LROW] = (bf16_t)(b.w >> 16);
        }
        f32x4 qk[2] = {(f32x4){0.f, 0.f, 0.f, 0.f}, (f32x4){0.f, 0.f, 0.f, 0.f}};
        if (type == 1) {
            *(LAS u32x4*)(QS + l * LROW + 8 * w) = A.q;
            *(LAS u32x4*)(KS + l * LROW + 8 * w) = A.k;
            __syncthreads();
#pragma unroll
            for (int i = 0; i < 2; ++i) { const int tt2 = (w & 1) * 2 + i;
                f32x4 a = (f32x4){0.f, 0.f, 0.f, 0.f};
                a = mma(frag(KS, 16 * st_ + lr, lq * 8), frag(QS, 16 * tt2 + lr, lq * 8), a);
                a = mma(frag(KS, 16 * st_ + lr, lq * 8 + 32), frag(QS, 16 * tt2 + lr, lq * 8 + 32), a);
                qk[i] = a; }
        }
        f32x4 hs[4];
#pragma unroll
        for (int i = 0; i < 4; ++i) hs[i] = (f32x4){0.f, 0.f, 0.f, 0.f};
        s2_dir<type>(lds, D0, 0, w, l, tt, vh, lr, lq, qk, hs);
        if (has_next) s2_loadD<type>(P, cgi + cstep, h, 0, w, l, vh, lr, lq, D0);
        s2_dir<type>(lds, D1, 1, w, l, tt, vh, lr, lq, qk, hs);
        float ssq = 0.f;
#pragma unroll
        for (int i = 0; i < 4; ++i) ssq += (hs[i][0] * hs[i][0] + hs[i][1] * hs[i][1]) + (hs[i][2] * hs[i][2] + hs[i][3] * hs[i][3]);
        ssq += __shfl_xor(ssq, 16); ssq += __shfl_xor(ssq, 32);
        if (lq == 0) RED[vh * 64 + 16 * tt + lr] = ssq;
        __syncthreads();
        const float tot = RED[16 * tt + lr] + RED[64 + 16 * tt + lr];
        const float rstd = rsqrtf(tot * (1.f / 128.f) + EPS);
        const size_t rowt = (size_t)64 * cgi + 16 * tt + lr;
#pragma unroll
        for (int i = 0; i < 4; ++i) { const int col = h * 128 + 16 * (4 * vh + i) + 4 * lq;
            const u32x2 gz = gzv[i];
            const f32x4 w4 = w4v[i];
            float g[4] = {bflo(gz.x), bfhi(gz.x), bflo(gz.y), bfhi(gz.y)};
            float o[4];
#pragma unroll
            for (int j = 0; j < 4; ++j) o[j] = hs[i][j] * rstd * w4[j] * (type == 0 ? siluf_(g[j]) : sigmoidf_(g[j]));
            u32x2 ov; ov.x = cvt_pk_bf16(o[0], o[1]); ov.y = cvt_pk_bf16(o[2], o[3]);
            *(u32x2*)(MIX + rowt * DM + type * 512 + col) = ov; }
        if (has_next) A = An;
    }
}

__global__ void __launch_bounds__(NTHR, 2) fwd_megakernel(Args P) {
    extern __shared__ __attribute__((aligned(16))) unsigned char lds_raw[];
    LAS unsigned char* lds = (LAS unsigned char*)lds_raw;
    const int tid = threadIdx.x, lane = tid & 63, wave = __builtin_amdgcn_readfirstlane(tid >> 6);
    const int G = gridDim.x, bx = blockIdx.x;
    const int gw = bx * NWAVES + wave, NGW = G * NWAVES;
    unsigned char* ws = P.ws;
    float* MOD = (float*)(ws + WS_MOD);
    bf16_t* WIN = (bf16_t*)(ws + WS_WIN); bf16_t* WOUT = (bf16_t*)(ws + WS_WOUT); bf16_t* W1 = (bf16_t*)(ws + WS_W1); bf16_t* W2 = (bf16_t*)(ws + WS_W2);
    bf16_t* XN = (bf16_t*)(ws + WS_XN); bf16_t* Z = (bf16_t*)(ws + WS_Z); bf16_t* MIX = (bf16_t*)(ws + WS_MIX);
    float* X1 = (float*)(ws + WS_X1); float* X2B = (float*)(ws + WS_X2B); bf16_t* U = (bf16_t*)(ws + WS_U);
    volatile LAS unsigned* bst = (volatile LAS unsigned*)(lds + 131072);
    if (tid < 2) bst[tid] = 0u;
    __syncthreads();
    const XcdBarrier bar = xcd_barrier_post((unsigned*)(ws + WS_BAR), bst);

    {
        LAS float* scr = (LAS float*)(lds + wave * 8448);
        LAS float* sc = (LAS float*)(lds + 8 * 8448);
        for (int i = tid; i < 3 * DM; i += NTHR) { const int c = i >> 10, k = i & 1023; const float v = (c == 0) ? P.c_ctx[k] : P.c[(c - 1) * DM + k]; sc[i] = v / (1.f + __expf(-v)); }
        __syncthreads();
        for (int it = gw; it < 1536; it += NGW) {
            const int cb = it >> 4, kc = it & 15, col = cb * 64 + lane;
            const float* wp = P.w_ada + (size_t)(kc * 64) * 6144 + col;
            float a0 = 0.f, a1 = 0.f, a2 = 0.f;
#pragma unroll 16
            for (int k = 0; k < 64; ++k) { const float wv = __builtin_nontemporal_load(wp + (size_t)k * 6144); a0 += sc[kc * 64 + k] * wv; a1 += sc[DM + kc * 64 + k] * wv; a2 += sc[2 * DM + kc * 64 + k] * wv; }
            unsafeAtomicAdd(MOD + col, a0); unsafeAtomicAdd(MOD + 6144 + col, a1); unsafeAtomicAdd(MOD + 2 * 6144 + col, a2);
        }
        constexpr int I_IN = (DM / 64) * (LDZ / 32), I_O = (DM / 64) * (DM / 32), I_1 = (DM / 64) * (DFF / 32), I_2 = (DFF / 64) * (DM / 32);
        const bool ff_later = (G > 96 + 32);
        for (int it = gw; it < I_IN + I_O + (ff_later ? 0 : I_1 + I_2); it += NGW) {
            int r = it;
            if (r < I_IN) { transpose_item(P.w_in, DM, DIN, LDZ, WIN, scr, r, lane); continue; } r -= I_IN;
            if (r < I_O) { transpose_item(P.w_out, DM, DM, DM, WOUT, scr, r, lane); continue; } r -= I_O;
            if (r < I_1) { transpose_item(P.w_ff1, DM, DFF, DFF, W1, scr, r, lane); continue; } r -= I_1;
            transpose_item(P.w_ff2, DFF, DM, DM, W2, scr, r, lane);
        }
    }
    xcd_barrier(bar);
    if (tid == 0) { unsigned okc = 1u; for (int j = 0; j < 8; ++j) okc &= (xb_ld((unsigned*)(ws + WS_BAR) + XB_XCNT(j)) == 32u) ? 1u : 0u; bst[4] = (G == 256) ? okc : 0u; }
    __syncthreads();
    const bool aff = (G == 256);
    const bool realx = __builtin_amdgcn_readfirstlane((int)bst[4]) != 0;
    const int ax = realx ? __builtin_amdgcn_readfirstlane((int)bst[3]) : (bx & 7), ali = realx ? __builtin_amdgcn_readfirstlane((int)bst[2]) : (bx >> 3);
    const bool lseam = aff && realx;
#define SEAM_LOCAL() do { if (lseam) xcd_local_barrier(bar); else xcd_barrier(bar); } while (0)
    const int vbx = aff ? (ax + 8 * ali) : bx;
    const int rm0 = aff ? 768 * ax + ali * NWAVES + wave : gw, rmstep = aff ? 256 : NGW, rmend = aff ? 768 * ax + 768 : NTOK;
    for (int rep_p1 = 0; rep_p1 < ((DUP & 2) ? 2 : 1); ++rep_p1) {
    if (DUP & 512) { for (int q = 0; q < 8; ++q) xcd_barrier(bar); }
    { const int lane = fresh_tid() & 63;
    for (int m = rm0; m < rmend; m += rmstep) {
        const float* xr = m < NPR ? P.x_prompt + (size_t)m * DM : P.x_sample + (size_t)(m - NPR) * DM;
        const int cond = m < NPR ? 0 : 1 + ((m - NPR) >> 10);
        norm_mod_row(xr, P.norm1_w, MOD + cond * 6144, P.b_ada, 0, 1024, XN + (size_t)m * DM, lane);
    } }
    SEAM_LOCAL();
    }
    for (int rep_p2 = 0; rep_p2 < ((DUP & 4) ? 2 : 1); ++rep_p2) {
    {
        pg8::Gemm g{XN, WIN, DM, DM, DM}; pg8::Order S; S.init(NTOK, LDZ, 1, G, vbx); S.halo = lseam ? 1 : 0;
        pg8::EpiBf16<0> E{Z, LDZ, (bf16_t*)(ws + WS_ZS)};
        pg8::gemm_phase(lds, g, S, E);
        constexpr int NU1 = (NTOK / 256) * (LDZ / 256);
        const int nbusy = NU1 - G;
        if (false && rep_p2 == 0 && nbusy >= 0 && nbusy < G && bx >= nbusy) {
            __syncthreads();
            LAS float* scr = (LAS float*)(lds + wave * 8448);
            constexpr int I_O = (DM / 64) * (DM / 32), I_1 = (DM / 64) * (DFF / 32), I_2 = (DFF / 64) * (DM / 32);
            const int lane2 = fresh_tid() & 63;
            for (int it = (bx - nbusy) * NWAVES + wave; it < I_O + I_1 + I_2; it += (G - nbusy) * NWAVES) {
                int r = it;
                if (r < I_O) { transpose_item(P.w_out, DM, DM, DM, WOUT, scr, r, lane2); continue; } r -= I_O;
                if (r < I_1) { transpose_item(P.w_ff1, DM, DFF, DFF, W1, scr, r, lane2); continue; } r -= I_1;
                transpose_item(P.w_ff2, DFF, DM, DM, W2, scr, r, lane2);
            }
        }
    }
    SEAM_LOCAL();
    }
    for (int rep_p3 = 0; rep_p3 < ((DUP & 8) ? 2 : 1); ++rep_p3) {
    {
        const int type = aff ? ((ali >> 2) & 1) : ((bx >> 2) & 1), h = aff ? (ali & 3) : (bx & 3);
        const int cq = aff ? 12 * ax + (ali >> 3) : (bx >> 3), cstep = aff ? 4 : (G >> 3), cend = aff ? 12 * ax + 12 : 96;
        __syncthreads();
        stage_weights(P, lds, type, h, fresh_tid());
        __syncthreads();
        if ((G & 7) == 0) { for (int cgi = cq; cgi < cend; cgi += cstep) { if (type == 0) scan1_item<0>(P, lds, cgi, h, lseam ? ax : -1); else scan1_item<1>(P, lds, cgi, h, lseam ? ax : -1); } }
    }
    xcd_barrier(bar);
    }
    for (int rep_p4 = 0; rep_p4 < ((DUP & 16) ? 2 : 1); ++rep_p4) {
    if (aff) {
        if (ax < 5) { for (int j = 0; j < 3; ++j) { const int k = ali * 3 + j, seq = 3 * ax + (k >> 5), r = k & 31; prefix_unit(P, 64 + ((r & 15) | (seq << 4) | ((r >> 4) << 8))); } }
        else { const int idx = (ax - 5) * 32 + ali; if (idx < 32) prefix_unit(P, 64 + ((idx & 15) | (15 << 4) | ((idx >> 4) << 8))); else prefix_unit(P, idx - 32); }
    }
    else if (bx < 64 && G > 64) prefix_unit(P, bx);
    else if (G > 64) { for (int u = 64 + (bx - 64); u < 576; u += G - 64) prefix_unit(P, u); }
    else { for (int u = bx; u < 576; u += G) prefix_unit(P, u); }
    xcd_barrier(bar);
    {
        const int type = aff ? ((ali >> 2) & 1) : ((bx >> 2) & 1), h = aff ? (ali & 3) : (bx & 3);
        const int cq = aff ? 12 * ax + (ali >> 3) : (bx >> 3), cstep = aff ? 4 : (G >> 3), cend = aff ? 12 * ax + 12 : 96;
        if ((G & 7) == 0) { if (type == 0) scan2_loop<0>(P, lds, h, cq, cstep, cend); else scan2_loop<1>(P, lds, h, cq, cstep, cend); }
    }
    SEAM_LOCAL();
    }
    for (int rep_p5 = 0; rep_p5 < ((DUP & 32) ? 2 : 1); ++rep_p5) {
    {
        pg8::Gemm g{MIX, WOUT, DM, DM, DM}; pg8::Order S; S.init(NTOK, DM, 1, G, vbx);
        pg8::EpiRes E{P.x_prompt, P.x_sample, X1, X1, MOD, P.b_ada, 2048, 0};
        pg8::gemm_phase(lds, g, S, E);
        const bool p5_idle = aff ? (ali >= 12) : (bx >= 96);
        const int p5_idx = aff ? (ali - 12) + 20 * ax : (bx - 96);
        if (G > 96 + 32 && p5_idle) {
            LAS float* scr = (LAS float*)(lds + wave * 8448);
            constexpr int I_1 = (DM / 64) * (DFF / 32), I_2 = (DFF / 64) * (DM / 32);
            const int lane2 = fresh_tid() & 63;
            for (int it = p5_idx * NWAVES + wave; it < I_1 + I_2; it += (G - 96) * NWAVES) {
                if (it < I_1) transpose_item(P.w_ff1, DM, DFF, DFF, W1, scr, it, lane2);
                else transpose_item(P.w_ff2, DFF, DM, DM, W2, scr, it - I_1, lane2);
            }
        }
    }
    SEAM_LOCAL();
    }
    for (int rep_p6 = 0; rep_p6 < ((DUP & 64) ? 2 : 1); ++rep_p6) {
    { const int lane = fresh_tid() & 63;
    for (int m = rm0; m < rmend; m += rmstep) {
        const int cond = m < NPR ? 0 : 1 + ((m - NPR) >> 10);
        norm_mod_row(X1 + (size_t)m * DM, P.norm2_w, MOD + cond * 6144, P.b_ada, 3072, 4096, XN + (size_t)m * DM, lane);
    } }
    xcd_barrier(bar);
    }
    for (int rep_p7 = 0; rep_p7 < ((DUP & 128) ? 2 : 1); ++rep_p7) {
    {
        pg8::Gemm g{XN, W1, DM, DM, DM}; pg8::Order S; S.init(NTOK, DFF, 1, G, vbx);
        pg8::EpiBf16<1> E{U, DFF};
        pg8::gemm_phase(lds, g, S, E);
    }
    SEAM_LOCAL();
    }
    {
        pg8::Gemm g{U, W2, DFF, DFF, DFF / 2}; pg8::Order S; S.init(NTOK, DM, 2, G, vbx);
        pg8::EpiRes E{nullptr, nullptr, X1, X2B, MOD, P.b_ada, 5120, 1};
        pg8::gemm_phase(lds, g, S, E);
    }
    SEAM_LOCAL();
    { const int lane = fresh_tid() & 63;
    for (int m = rm0; m < rmend; m += rmstep) {
        const f32x4* xa = (const f32x4*)(X1 + (size_t)m * DM) + lane; const f32x4* xb = (const f32x4*)(X2B + (size_t)m * DM) + lane;
        f32x4 v[4]; float s = 0.f;
#pragma unroll
        for (int j = 0; j < 4; ++j) { v[j] = xa[64 * j] + xb[64 * j]; s += (v[j].x * v[j].x + v[j].y * v[j].y) + (v[j].z * v[j].z + v[j].w * v[j].w); }
        const float rstd = rsqrtf(wave_sum(s) * (1.f / DM) + EPS);
        f32x4* o = (f32x4*)(P.out + (size_t)m * DM) + lane;
#pragma unroll
        for (int j = 0; j < 4; ++j) o[64 * j] = v[j] * rstd * *(const f32x4*)(P.final_norm_w + 4 * lane + 256 * j);
    } }
}

extern "C" void kernel_launch(void* const* d_in, const int* in_sizes, int n_in, void* d_out, int out_size, void* d_ws, size_t ws_size, hipStream_t stream) {
    static int grid = 0;
    if (grid == 0) {
        int dev = 0, cus = 0, per_cu = 0;
        hipGetDevice(&dev);
        hipDeviceGetAttribute(&cus, hipDeviceAttributeMultiprocessorCount, dev);
        if (hipFuncSetAttribute((const void*)fwd_megakernel, hipFuncAttributeMaxDynamicSharedMemorySize, LDS_BYTES) != hipSuccess) { fprintf(stderr, "hipFuncSetAttribute failed\n"); grid = -1; return; }
        if (hipOccupancyMaxActiveBlocksPerMultiprocessor(&per_cu, (const void*)fwd_megakernel, NTHR, LDS_BYTES) != hipSuccess || per_cu < 1) { fprintf(stderr, "occupancy query: %d blocks per CU\n", per_cu); grid = -1; return; }
        grid = cus;
        if (n_in != 23 || ws_size < WS_END) { fprintf(stderr, "unexpected inputs / workspace\n"); grid = -1; return; }
    }
    if (grid < 0) return;
    (void)hipMemsetAsync((char*)d_ws + WS_MOD, 0, WS_ZERO_BYTES, stream);
    Args a{};
    const float* const* in = (const float* const*)d_in;
    a.x_prompt = in[0]; a.x_sample = in[1]; a.c = in[2]; a.st_gla = in[3]; a.st_C = in[4]; a.st_n = in[5]; a.st_m = in[6]; a.c_ctx = in[7];
    a.w_ada = in[8]; a.b_ada = in[9]; a.norm1_w = in[10]; a.norm2_w = in[11]; a.w_in = in[12]; a.w_alpha2 = in[13]; a.b_alpha = in[14]; a.b_mgate = in[15];
    a.conv_w = in[16]; a.gnorm_a_w = in[17]; a.gnorm_b_w = in[18]; a.w_out = in[19]; a.w_ff1 = in[20]; a.w_ff2 = in[21]; a.final_norm_w = in[22];
    a.out = (float*)d_out; a.ws = (unsigned char*)d_ws;
    void* args[] = {&a};
    hipError_t e = hipLaunchCooperativeKernel((const void*)fwd_megakernel, dim3(grid), dim3(NTHR), args, LDS_BYTES, stream);
    if (e != hipSuccess) fprintf(stderr, "cooperative launch failed: %s (grid %d)\n", hipGetErrorString(e), grid);
}
```
